# Optimizing an MI355X kernel written in HIP

```python
import jax, jax.numpy as jnp
from jax import lax
import numpy as np

D_MODEL = 2048
BATCH = 16
SEQ = 2048
DEPTH = 1
DEC_BATCH = 32
DEC_SEQ = 32
PAST_LEN = 1024

CHUNK = 64
POOL_WINDOWS = (2, 4, 8, 16)
N_POOL_GROUPS = 4
POOL_WIDTH = D_MODEL // 2
POOL_GROUP = POOL_WIDTH // N_POOL_GROUPS
POOL_STATE = max(POOL_WINDOWS) - 1
MLSTM_HEADS = 8
MLSTM_WIDTH = D_MODEL
MLSTM_HEAD_DIM = MLSTM_WIDTH // MLSTM_HEADS
D_FF = -(-8 * D_MODEL // (3 * 256)) * 256
ALPHA = (2 * DEPTH) ** 0.25
BETA = (8 * DEPTH) ** -0.25
LN_EPS = 1e-5
SPLIT_IDX = [POOL_WIDTH,
             POOL_WIDTH + MLSTM_WIDTH,
             POOL_WIDTH + 2 * MLSTM_WIDTH,
             POOL_WIDTH + 3 * MLSTM_WIDTH,
             POOL_WIDTH + 4 * MLSTM_WIDTH,
             POOL_WIDTH + 4 * MLSTM_WIDTH + MLSTM_HEADS,
             POOL_WIDTH + 4 * MLSTM_WIDTH + 2 * MLSTM_HEADS,
             POOL_WIDTH + 4 * MLSTM_WIDTH + 2 * MLSTM_HEADS + D_MODEL]
N_IN = POOL_WIDTH + 4 * MLSTM_WIDTH + 2 * MLSTM_HEADS + 2 * D_MODEL

kernel_name = "pool_mlstm_gated_deepnorm_adaln_stream_step"


def layer_norm(x, g=None, b=None):
    xf = x.astype(jnp.float32)
    mu = jnp.mean(xf, axis=-1, keepdims=True)
    var = jnp.mean(jnp.square(xf - mu), axis=-1, keepdims=True)
    y = (xf - mu) * lax.rsqrt(var + LN_EPS)
    if g is not None:
        y = y * g.astype(jnp.float32) + b.astype(jnp.float32)
    return y.astype(x.dtype)


def pool_mixer(p, prefix, start_pos, w_pool, pool_scale):
    B, L, _ = p.shape
    ext = jnp.concatenate([prefix.astype(p.dtype), p], axis=1)
    ef = ext.astype(jnp.float32)
    cs = jnp.concatenate([jnp.zeros_like(ef[:, :1]), jnp.cumsum(ef, axis=1)], axis=1)
    pos = start_pos + jnp.arange(L)
    hi = cs[:, POOL_STATE + 1:POOL_STATE + 1 + L]
    tok = ef[:, POOL_STATE:]
    outs = []
    for g, w in enumerate(POOL_WINDOWS):
        sl = slice(g * POOL_GROUP, (g + 1) * POOL_GROUP)
        lo = cs[:, POOL_STATE + 1 - w:POOL_STATE + 1 - w + L, sl]
        cnt = jnp.minimum(pos + 1, w).astype(jnp.float32)[None, :, None]
        outs.append((hi[..., sl] - lo) / cnt - tok[..., sl])
    y = jnp.stack(outs, axis=2).astype(p.dtype)
    y = jnp.einsum('blgc,gcd->blgd', y, w_pool).reshape(B, L, POOL_WIDTH) * pool_scale
    return y, ext[:, -POOL_STATE:]


def mlstm_chunk(carry, inp):
    C, n, m = carry
    q, k, v, ig, lf = inp
    L = q.shape[2]
    b = jnp.cumsum(lf, axis=-1)
    a = b + m[..., None]
    causal = jnp.tril(jnp.ones((L, L), dtype=bool))
    log_d = jnp.where(causal, b[..., :, None] - b[..., None, :] + ig[..., None, :], -jnp.inf)
    m_row = jnp.maximum(a, jnp.max(log_d, axis=-1))
    d = jnp.exp(log_d - m_row[..., None])
    w_inter = jnp.exp(a - m_row)
    s = jnp.einsum('bhld,bhsd->bhls', q, k) * d
    num = w_inter[..., None] * jnp.einsum('bhld,bhde->bhle', q, C) + jnp.einsum('bhls,bhse->bhle', s, v)
    den = w_inter * jnp.einsum('bhld,bhd->bhl', q, n) + jnp.sum(s, axis=-1)
    h = num / jnp.maximum(jnp.abs(den), jnp.exp(-m_row))[..., None]
    m_new = m_row[..., -1]
    w_s = jnp.exp(b[..., -1:] - b + ig - m_new[..., None])
    decay = jnp.exp(b[..., -1] + m - m_new)
    kw = k * w_s[..., None]
    C_new = decay[..., None, None] * C + jnp.einsum('bhsd,bhse->bhde', kw, v)
    n_new = decay[..., None] * n + jnp.sum(kw, axis=2)
    return (C_new, n_new, m_new), h


def mlstm_seq(q, k, v, ig, lf, C, n, m):
    L = q.shape[2]
    if L <= CHUNK:
        (C, n, m), h = mlstm_chunk((C, n, m), (q, k, v, ig, lf))
        return h, C, n, m
    nc = L // CHUNK
    def split(t):
        return jnp.moveaxis(t.reshape(t.shape[:2] + (nc, CHUNK) + t.shape[3:]), 2, 0)
    (C, n, m), h = lax.scan(mlstm_chunk, (C, n, m), (split(q), split(k), split(v), split(ig), split(lf)))
    h = jnp.moveaxis(h, 0, 2).reshape(q.shape[:2] + (L, q.shape[-1]))
    return h, C, n, m


def token_mixer(u, pool_prefix, C0, n0, m0, start_pos, w_in, b_i, b_f, w_pool, pool_scale, gn_w, w_pa, w_pb, w_out):
    B, L, _ = u.shape
    f32 = jnp.float32
    proj = u @ w_in
    p, q, k, v, o, ig, fg, ga, gb = jnp.split(proj, SPLIT_IDX, axis=-1)
    a_out, pool_state = pool_mixer(p, pool_prefix, start_pos, w_pool, pool_scale)
    def heads(t):
        return jnp.swapaxes(t.reshape(B, L, MLSTM_HEADS, MLSTM_HEAD_DIM).astype(f32), 1, 2)
    ig_t = jnp.swapaxes((ig + b_i).astype(f32), 1, 2)
    lf_t = jax.nn.log_sigmoid(jnp.swapaxes((fg + b_f).astype(f32), 1, 2))
    h, C, n, m = mlstm_seq(heads(q), heads(k) * (MLSTM_HEAD_DIM ** -0.5), heads(v), ig_t, lf_t,
                           C0.astype(f32), n0.astype(f32), m0.astype(f32))
    h = jnp.swapaxes(h, 1, 2)
    h = h * jax.nn.sigmoid(o.astype(f32)).reshape(B, L, MLSTM_HEADS, MLSTM_HEAD_DIM)
    mu = jnp.mean(h, axis=-1, keepdims=True)
    var = jnp.mean(jnp.square(h - mu), axis=-1, keepdims=True)
    h = (h - mu) * lax.rsqrt(var + LN_EPS) * gn_w.astype(f32).reshape(MLSTM_HEADS, MLSTM_HEAD_DIM)
    b_out = h.reshape(B, L, MLSTM_WIDTH).astype(u.dtype)
    merged = jax.nn.sigmoid(ga) * (a_out @ w_pa) + jax.nn.sigmoid(gb) * (b_out @ w_pb)
    return merged @ w_out, pool_state, C.astype(u.dtype), n.astype(u.dtype), m.astype(u.dtype)


def layer(x, c, pool_prefix, C0, n0, m0, start_pos, w_ada, b_ada, w_in, b_i, b_f, w_pool, pool_scale, gn_w,
          w_pa, w_pb, w_out, ln1_g, ln1_b, w_gate, w_up, w_down, ln2_g, ln2_b):
    mod = jax.nn.silu(c) @ w_ada + b_ada
    sh1, sc1, g1, sh2, sc2, g2 = [t[:, None, :] for t in jnp.split(mod, 6, axis=-1)]
    u = layer_norm(x) * (1 + sc1) + sh1
    t, pool_state, C, n, m = token_mixer(u, pool_prefix, C0, n0, m0, start_pos, w_in, b_i, b_f, w_pool,
                                         pool_scale, gn_w, w_pa, w_pb, w_out)
    x = layer_norm(ALPHA * x + g1 * t, ln1_g, ln1_b)
    u = layer_norm(x) * (1 + sc2) + sh2
    f = (jax.nn.silu(u @ w_gate) * (u @ w_up)) @ w_down
    x = layer_norm(ALPHA * x + g2 * f, ln2_g, ln2_b)
    return x, pool_state, C, n, m


def setup_inputs(seed: int = 0) -> dict:
    key = jax.random.key(seed)
    ks = jax.random.split(key, 32)
    f32 = jnp.float32
    def nrm(k, shape, s):
        return jax.random.normal(k, shape, f32) * s
    return {
        "x_prompt": nrm(ks[0], (BATCH, SEQ, D_MODEL), 1.0),
        "x_sample": nrm(ks[1], (DEC_BATCH, DEC_SEQ, D_MODEL), 1.0),
        "c_prompt": nrm(ks[2], (BATCH, D_MODEL), 1.0),
        "c_sample": nrm(ks[3], (DEC_BATCH, D_MODEL), 1.0),
        "state_pool": nrm(ks[4], (DEPTH, DEC_BATCH, POOL_STATE, POOL_WIDTH), 1.0),
        "state_mlstm_C": nrm(ks[5], (DEPTH, DEC_BATCH, MLSTM_HEADS, MLSTM_HEAD_DIM, MLSTM_HEAD_DIM), 0.05),
        "state_mlstm_n": nrm(ks[6], (DEPTH, DEC_BATCH, MLSTM_HEADS, MLSTM_HEAD_DIM), 0.05),
        "state_mlstm_m": nrm(ks[7], (DEPTH, DEC_BATCH, MLSTM_HEADS), 0.5),
        "w_ada": nrm(ks[8], (DEPTH, D_MODEL, 6 * D_MODEL), 0.5 * D_MODEL ** -0.5),
        "b_ada": nrm(ks[9], (DEPTH, 6 * D_MODEL), 0.02),
        "w_in": nrm(ks[10], (DEPTH, D_MODEL, N_IN), D_MODEL ** -0.5),
        "b_i": nrm(ks[11], (DEPTH, MLSTM_HEADS), 0.1),
        "b_f": jnp.linspace(3.0, 6.0, MLSTM_HEADS, dtype=f32)[None, :] + nrm(ks[12], (DEPTH, MLSTM_HEADS), 0.01),
        "w_pool": nrm(ks[13], (DEPTH, N_POOL_GROUPS, POOL_GROUP, POOL_GROUP), POOL_GROUP ** -0.5),
        "pool_scale": 1.0 + nrm(ks[14], (DEPTH, POOL_WIDTH), 0.02),
        "gn_w": 1.0 + nrm(ks[15], (DEPTH, MLSTM_WIDTH), 0.02),
        "w_pa": nrm(ks[16], (DEPTH, POOL_WIDTH, D_MODEL), POOL_WIDTH ** -0.5),
        "w_pb": nrm(ks[17], (DEPTH, MLSTM_WIDTH, D_MODEL), MLSTM_WIDTH ** -0.5),
        "w_out": nrm(ks[18], (DEPTH, D_MODEL, D_MODEL), BETA * D_MODEL ** -0.5),
        "ln1_g": 1.0 + nrm(ks[19], (DEPTH, D_MODEL), 0.02),
        "ln1_b": nrm(ks[20], (DEPTH, D_MODEL), 0.02),
        "w_gate": nrm(ks[21], (DEPTH, D_MODEL, D_FF), D_MODEL ** -0.5),
        "w_up": nrm(ks[22], (DEPTH, D_MODEL, D_FF), D_MODEL ** -0.5),
        "w_down": nrm(ks[23], (DEPTH, D_FF, D_MODEL), BETA * D_FF ** -0.5),
        "ln2_g": 1.0 + nrm(ks[24], (DEPTH, D_MODEL), 0.02),
        "ln2_b": nrm(ks[25], (DEPTH, D_MODEL), 0.02),
    }


def reference(x_prompt, x_sample, c_prompt, c_sample, state_pool, state_mlstm_C, state_mlstm_n, state_mlstm_m,
              w_ada, b_ada, w_in, b_i, b_f, w_pool, pool_scale, gn_w, w_pa, w_pb, w_out, ln1_g, ln1_b,
              w_gate, w_up, w_down, ln2_g, ln2_b):
    B = x_prompt.shape[0]
    y_prompt, y_sample = x_prompt, x_sample
    pool_p_l, C_p_l, n_p_l, m_p_l = [], [], [], []
    pool_s_l, C_s_l, n_s_l, m_s_l = [], [], [], []
    for l in range(DEPTH):
        wl = (w_ada[l], b_ada[l], w_in[l], b_i[l], b_f[l], w_pool[l], pool_scale[l], gn_w[l], w_pa[l], w_pb[l],
              w_out[l], ln1_g[l], ln1_b[l], w_gate[l], w_up[l], w_down[l], ln2_g[l], ln2_b[l])
        prefix0 = jnp.zeros((B, POOL_STATE, POOL_WIDTH), x_prompt.dtype)
        C0 = jnp.zeros((B, MLSTM_HEADS, MLSTM_HEAD_DIM, MLSTM_HEAD_DIM), jnp.float32)
        n0 = jnp.zeros((B, MLSTM_HEADS, MLSTM_HEAD_DIM), jnp.float32)
        m0 = jnp.zeros((B, MLSTM_HEADS), jnp.float32)
        y_prompt, ps, Cp, npp, mp = layer(y_prompt, c_prompt, prefix0, C0, n0, m0, 0, *wl)
        y_sample, ss, Cs, ns, ms = layer(y_sample, c_sample, state_pool[l], state_mlstm_C[l], state_mlstm_n[l],
                                         state_mlstm_m[l], PAST_LEN, *wl)
        pool_p_l.append(ps); C_p_l.append(Cp); n_p_l.append(npp); m_p_l.append(mp)
        pool_s_l.append(ss); C_s_l.append(Cs); n_s_l.append(ns); m_s_l.append(ms)
    pool_p = jnp.stack(pool_p_l, axis=0)
    C_p = jnp.stack(C_p_l, axis=0)
    n_p = jnp.stack(n_p_l, axis=0)
    m_p = jnp.stack(m_p_l, axis=0)
    pool_s = jnp.stack(pool_s_l, axis=0)
    C_s = jnp.stack(C_s_l, axis=0)
    n_s = jnp.stack(n_s_l, axis=0)
    m_s = jnp.stack(m_s_l, axis=0)
    return (y_prompt, y_sample, pool_p, C_p, n_p, m_p, pool_s, C_s, n_s, m_s)
```

```cpp
#include <hip/hip_runtime.h>
#include <hip/hip_cooperative_groups.h>
#include <cstdio>
namespace cg = cooperative_groups;

#ifndef PG8_SP2
#define PG8_SP2 true
#endif
#ifndef PG8_ALIGN
#define PG8_ALIGN true
#endif
#ifndef ONE_LAUNCH
#define ONE_LAUNCH 1
#endif

#ifndef REPEAT_PHASE
#define REPEAT_PHASE -1
#endif
#define REP(k) for (int rep_##k = 0; rep_##k < ((REPEAT_PHASE == (k)) ? 2 : 1); ++rep_##k)
#define LAS __attribute__((address_space(3)))
typedef unsigned short bf16_t;
typedef short bf16x8 __attribute__((ext_vector_type(8)));
typedef float f32x4 __attribute__((ext_vector_type(4)));
typedef unsigned u32x4 __attribute__((ext_vector_type(4)));
typedef unsigned u32x2 __attribute__((ext_vector_type(2)));

constexpr int D = 2048, MP = 16 * 2048, MS = 32 * 32, M = MP + MS;
constexpr int SEQ = 2048, DSEQ = 32, PW = 1024, HD = 256, DFF = 5632, NIN = 13328, NMAIN = 13312;
constexpr int MODW = 6 * D;
constexpr float ALPHA = 1.18920711500272f, LN_EPS = 1e-5f;
constexpr int NTHREADS = 512, LDS_BYTES = 144 * 1024;
constexpr int NPHASES = 12;

constexpr size_t SZ_TOK = (size_t)M * D * 2;
constexpr size_t WS_MOD = 16384;
constexpr size_t WS_GATES = WS_MOD + (size_t)48 * MODW * 4;
constexpr size_t WS_WIN = WS_GATES + (size_t)M * 16 * 4;
constexpr size_t WS_WPOOL = WS_WIN + (size_t)NMAIN * D * 2;
constexpr size_t WS_WPA = WS_WPOOL + (size_t)4 * 256 * 256 * 2;
constexpr size_t WS_WPB = WS_WPA + (size_t)D * PW * 2;
constexpr size_t WS_WOUT = WS_WPB + (size_t)D * D * 2;
constexpr size_t WS_WGU = WS_WOUT + (size_t)D * D * 2;
constexpr size_t WS_WDOWN = WS_WGU + (size_t)2 * DFF * D * 2;
constexpr size_t WS_U = WS_WDOWN + (size_t)D * DFF * 2;
constexpr size_t WS_Q = WS_U + SZ_TOK;
constexpr size_t WS_K = WS_Q + SZ_TOK;
constexpr size_t WS_O = WS_K + SZ_TOK;
constexpr size_t WS_GA = WS_O + SZ_TOK;
constexpr size_t WS_GB = WS_GA + SZ_TOK;
constexpr size_t WS_PART = WS_GB + SZ_TOK;
constexpr size_t WS_END = WS_PART + (size_t)8 * MS * D * 4;
constexpr size_t OUT_POOLP = (size_t)M * D;
constexpr size_t OUT_CP = OUT_POOLP + (size_t)16 * 15 * PW;
constexpr size_t OUT_NP = OUT_CP + (size_t)16 * 8 * 256 * 256;
constexpr size_t OUT_MP = OUT_NP + (size_t)16 * 8 * 256;
constexpr size_t OUT_POOLS = OUT_MP + 16 * 8;
constexpr size_t OUT_CS = OUT_POOLS + (size_t)32 * 15 * PW;
constexpr size_t OUT_NS = OUT_CS + (size_t)32 * 8 * 256 * 256;
constexpr size_t OUT_MS = OUT_NS + (size_t)32 * 8 * 256;
constexpr size_t OUT_END = OUT_MS + 32 * 8;

__device__ __forceinline__ unsigned cvt_pk_bf16(float lo, float hi) { unsigned r; asm volatile("v_cvt_pk_bf16_f32 %0, %1, %2" : "=v"(r) : "v"(lo), "v"(hi)); return r; }
__device__ __forceinline__ float bf_lo(unsigned w) { return __uint_as_float(w << 16); }
__device__ __forceinline__ float bf_hi(unsigned w) { return __uint_as_float(w & 0xffff0000u); }
__device__ __forceinline__ float sigmoidf_(float x) { return 1.0f / (1.0f + __expf(-x)); }
__device__ __forceinline__ int cond_of_row(int r) { return r < MP ? (r >> 11) : 16 + ((r - MP) >> 5); }
__device__ __forceinline__ float wave_sum(float v) {
#pragma unroll
    for (int o = 32; o >= 1; o >>= 1) v += __shfl_xor(v, o);
    return v;
}
__device__ __forceinline__ f32x4 mfma16(bf16x8 a, bf16x8 b, f32x4 c) { return __builtin_amdgcn_mfma_f32_16x16x32_bf16(a, b, c, 0, 0, 0); }
__device__ __forceinline__ bf16x8 as_bf16x8(u32x4 v) { return __builtin_bit_cast(bf16x8, v); }

namespace pg8 {
constexpr int BM = 256, BK = 64, HALF = 128, HTB = HALF * BK * 2, STAGE_BYTES = 8 * HTB, NXCD = 8, WGM = 8;
__host__ __device__ __forceinline__ int lds_byte(int r, int c) { const int st = (r >> 4) * 2 + (c >> 5), rr = r & 15, cc = c & 31, ob = rr * 64 + cc * 2; return st * 1024 + (ob ^ (((ob >> 9) & 1) << 5)); }
__host__ __device__ __forceinline__ void stage_rc(int b, int& R, int& C) { const int st = b / 1024, sb = b % 1024, swz = sb ^ (((sb >> 9) & 1) << 5); R = (st >> 1) * 16 + swz / 64; C = (st & 1) * 32 + (swz % 64) / 2; }
__host__ __device__ __forceinline__ int perm32(int rho) { const int n = rho >> 4, i = rho & 15; return 8 * (i >> 2) + 4 * n + (i & 3); }

struct Unit { int pm, pn, kb; };
struct Gemm { const bf16_t* A; const bf16_t* Bt; int lda, ldb, K, acs, Ksub; };

struct StaticOrder {
    int nM, nN, nwg, G, c;
    __device__ void init(int nM_, int nN_, int G_, int c_) { nM = nM_; nN = nN_; nwg = nM * nN; G = G_; c = c_; }
    __device__ bool next(int i, Unit& u) const {
        const long L = (long)i * G + c; if (L >= nwg) return false;
        int wgid = (int)L; { const int q = nwg / NXCD, r = nwg % NXCD, xcd = wgid % NXCD, off = wgid / NXCD; wgid = (xcd < r ? xcd * (q + 1) : r * (q + 1) + (xcd - r) * q) + off; }
        const int nig = WGM * nN, gid = wgid / nig, fm = gid * WGM, gsz = (nM - fm) < WGM ? (nM - fm) : WGM;
        u.pm = fm + ((wgid % nig) % gsz); u.pn = (wgid % nig) / gsz; u.kb = -1; return true;
    }
};
struct SplitOrder {
    StaticOrder main; int nMs, ns, nsub;
    __device__ void init(int nM_, int nN_, int nMs_, int ns_, int G_, int c_) { main.init(nM_, nN_, G_, c_); nMs = nMs_; ns = ns_; nsub = nMs_ * nN_ * ns_; }
    __device__ bool next(int i, Unit& u) const {
        const long L = (long)i * main.G + main.c;
        if (L < main.nwg) return main.next(i, u);
        const int j = (int)(L - main.nwg); if (j >= nsub) return false;
        u.pn = j % main.nN; u.pm = main.nM + (j / main.nN) % nMs; u.kb = j / (main.nN * nMs); return true;
    }
};
struct NoSub { template <class A> __device__ __forceinline__ void operator()(const A&, const Unit&, int, int, int, int) const {} };

template <class Epi, class Sched = StaticOrder, class EpiSub = NoSub, bool FAST = false>
__device__ __forceinline__ void gemm_phase(LAS unsigned char* lds, const Gemm g, const Sched& S, const Epi& E, const EpiSub& ES = EpiSub()) {
    const int tid = threadIdx.x, wid = __builtin_amdgcn_readfirstlane(tid >> 6), lane = tid & 63, wr = wid >> 2, wc = wid & 3, fr = lane & 15, fq = lane >> 4;
    const int ntMain = g.K / BK, ntSub = g.Ksub / BK; const size_t ksubB = (size_t)g.Ksub * 2;
    unsigned voffA[2], voffB[2];
#pragma unroll
    for (int i = 0; i < 2; ++i) { int R, C; stage_rc(tid * 16 + i * 8192, R, C); const int Rb = Epi::PERM ? ((R & ~31) + perm32(R & 31)) : R;
        voffA[i] = (unsigned)(R * g.lda + C) * 2u; voffB[i] = (unsigned)(Rb * g.ldb + C) * 2u; }
    const size_t kstep = (size_t)(BK * 2);
    const size_t hstepA = (size_t)HALF * g.lda * 2, hstepB = (size_t)HALF * g.ldb * 2;
    const size_t tstepA = 2 * hstepA, tstepB = 2 * hstepB;
    const unsigned ldsw = (unsigned)wid * 1024u;
    const int aoff = lds_byte(wr * 64 + fr, fq * 8), boff = lds_byte(wc * 32 + fr, fq * 8);
#define PG8_SA(b, h) (((b) * 2 + (h)) * HTB)
#define PG8_SB(b, h) ((4 + (b) * 2 + (h)) * HTB)
#define PG8_STAGE(bufoff, gbase, voff) do { _Pragma("unroll") for (int _i = 0; _i < 2; ++_i) \
        __builtin_amdgcn_global_load_lds((const unsigned*)((const char*)(gbase) + (voff)[_i]), (LAS unsigned*)(lds + (bufoff) + ldsw + _i * 8192), 16, 0, 0); } while (0)
#define PG8_LDA(dst, b, h) do { _Pragma("unroll") for (int m = 0; m < 4; ++m) _Pragma("unroll") for (int k = 0; k < 2; ++k) dst[m][k] = *(const LAS bf16x8*)(lds + PG8_SA(b, h) + aoff + m * 2048 + k * 1024); } while (0)
#define PG8_LDB(dst, b, h) do { _Pragma("unroll") for (int n = 0; n < 2; ++n) _Pragma("unroll") for (int k = 0; k < 2; ++k) dst[n][k] = *(const LAS bf16x8*)(lds + PG8_SB(b, h) + boff + n * 2048 + k * 1024); } while (0)
#define PG8_MMA(ai, bj, At, Bt) do { __builtin_amdgcn_s_setprio(1); _Pragma("unroll") for (int m = 0; m < 4; ++m) _Pragma("unroll") for (int n = 0; n < 2; ++n) _Pragma("unroll") for (int k = 0; k < 2; ++k) \
        acc[ai][bj][m][n] = __builtin_amdgcn_mfma_f32_16x16x32_bf16(Bt[n][k], At[m][k], acc[ai][bj][m][n], 0, 0, 0); __builtin_amdgcn_s_setprio(0); } while (0)
#define PG8_WAIT_V(n) asm volatile("s_waitcnt vmcnt(" #n ")" ::: "memory")
#define PG8_WAIT_L(n) asm volatile("s_waitcnt lgkmcnt(" #n ")" ::: "memory")
#define PG8_BAR __builtin_amdgcn_s_barrier()
#define PG8_SCHED __builtin_amdgcn_sched_barrier(0)
    Unit cur, nxt; int ui = 0;
    if (!S.next(0, cur)) return;
    f32x4 acc[2][2][4][2];
#pragma unroll
    for (int a = 0; a < 2; ++a)
#pragma unroll
        for (int b = 0; b < 2; ++b)
#pragma unroll
            for (int m = 0; m < 4; ++m)
#pragma unroll
                for (int n = 0; n < 2; ++n) acc[a][b][m][n] = (f32x4){0.f, 0.f, 0.f, 0.f};
    bf16x8 At[4][2], B0[2][2], B1[2][2];
    const char* cA = (const char*)g.A + (size_t)cur.pm * tstepA + (size_t)cur.pn * g.acs + (cur.kb < 0 ? 0 : cur.kb * ksubB); const char* cB = (const char*)g.Bt + (size_t)cur.pn * tstepB + (cur.kb < 0 ? 0 : cur.kb * ksubB);
    if constexpr (FAST && PG8_SP2) {
        PG8_STAGE(PG8_SB(0, 0), cB, voffB); PG8_STAGE(PG8_SB(0, 1), cB + hstepB, voffB); PG8_STAGE(PG8_SA(0, 0), cA, voffA); PG8_STAGE(PG8_SA(0, 1), cA + hstepA, voffA);
        if (wr == 1) PG8_BAR;
        PG8_WAIT_V(2); PG8_BAR;
        PG8_STAGE(PG8_SB(1, 0), cB + kstep, voffB); PG8_STAGE(PG8_SA(1, 0), cA + kstep, voffA); PG8_STAGE(PG8_SB(1, 1), cB + hstepB + kstep, voffB);
        PG8_WAIT_V(6); PG8_BAR;
    } else {
    PG8_STAGE(PG8_SB(0, 0), cB, voffB); PG8_STAGE(PG8_SA(0, 0), cA, voffA); PG8_STAGE(PG8_SB(0, 1), cB + hstepB, voffB); PG8_STAGE(PG8_SA(0, 1), cA + hstepA, voffA);
    if (wr == 1) PG8_BAR;
    PG8_WAIT_V(4); PG8_BAR;
    PG8_STAGE(PG8_SB(1, 0), cB + kstep, voffB); PG8_STAGE(PG8_SA(1, 0), cA + kstep, voffA); PG8_STAGE(PG8_SB(1, 1), cB + hstepB + kstep, voffB);
    PG8_WAIT_V(6); PG8_BAR;
    }
    for (;;) {
        const bool has_next = S.next(ui + 1, nxt);
        const size_t nko = (has_next && nxt.kb >= 0) ? nxt.kb * ksubB : 0;
        const char* nA = has_next ? (const char*)g.A + (size_t)nxt.pm * tstepA + (size_t)nxt.pn * g.acs + nko : cA; const char* nB = has_next ? (const char*)g.Bt + (size_t)nxt.pn * tstepB + nko : cB;
        const int nt = cur.kb < 0 ? ntMain : ntSub;
        for (int t = 0; t < nt; t += 2) {
            const bool last = (t == nt - 2);
            const char* a1 = cA + (size_t)(t + 1) * kstep;
            const char* a2 = last ? nA : cA + (size_t)(t + 2) * kstep; const char* b2 = last ? nB : cB + (size_t)(t + 2) * kstep;
            const char* a3 = a2 + kstep; const char* b3 = b2 + kstep;
            if constexpr (FAST && PG8_SP2) {
            PG8_LDB(B0, 0, 0); PG8_LDB(B1, 0, 1); PG8_SCHED; PG8_LDA(At, 0, 0); PG8_STAGE(PG8_SA(1, 1), a1 + hstepA, voffA);
            PG8_WAIT_V(8); PG8_WAIT_L(0); PG8_BAR; PG8_MMA(0, 0, At, B0); PG8_MMA(0, 1, At, B1); PG8_BAR; PG8_SCHED;
            PG8_LDA(At, 0, 1); PG8_STAGE(PG8_SB(0, 0), b2, voffB); PG8_STAGE(PG8_SB(0, 1), b2 + hstepB, voffB); PG8_STAGE(PG8_SA(0, 0), a2, voffA);
            PG8_WAIT_V(8); PG8_WAIT_L(0); PG8_BAR; PG8_MMA(1, 0, At, B0); PG8_MMA(1, 1, At, B1); PG8_BAR; PG8_SCHED;
            PG8_LDB(B0, 1, 0); PG8_LDB(B1, 1, 1); PG8_SCHED; PG8_LDA(At, 1, 0); PG8_STAGE(PG8_SA(0, 1), a2 + hstepA, voffA);
            PG8_WAIT_V(8); PG8_WAIT_L(0); PG8_BAR; PG8_MMA(0, 0, At, B0); PG8_MMA(0, 1, At, B1); PG8_BAR; PG8_SCHED;
            PG8_LDA(At, 1, 1); PG8_STAGE(PG8_SB(1, 0), b3, voffB); PG8_STAGE(PG8_SB(1, 1), b3 + hstepB, voffB); PG8_STAGE(PG8_SA(1, 0), a3, voffA);
            PG8_WAIT_V(8); PG8_WAIT_L(0); PG8_BAR; PG8_MMA(1, 0, At, B0); PG8_MMA(1, 1, At, B1); PG8_BAR; PG8_SCHED;
            } else {
            PG8_LDB(B0, 0, 0); PG8_SCHED; PG8_LDA(At, 0, 0); PG8_STAGE(PG8_SA(1, 1), a1 + hstepA, voffA);
            PG8_WAIT_L(8); PG8_BAR; PG8_WAIT_L(0); PG8_MMA(0, 0, At, B0); PG8_BAR; PG8_SCHED;
            PG8_LDB(B1, 0, 1); PG8_STAGE(PG8_SB(0, 0), b2, voffB);
            PG8_BAR; PG8_WAIT_L(0); PG8_MMA(0, 1, At, B1); PG8_BAR;
            PG8_LDA(At, 0, 1); PG8_STAGE(PG8_SA(0, 0), a2, voffA);
            PG8_BAR; PG8_WAIT_L(0); PG8_MMA(1, 0, At, B0); PG8_BAR; PG8_SCHED;
            PG8_STAGE(PG8_SB(0, 1), b2 + hstepB, voffB);
            PG8_WAIT_V(6); PG8_BAR; PG8_MMA(1, 1, At, B1); PG8_BAR;
            PG8_LDB(B0, 1, 0); PG8_SCHED; PG8_LDA(At, 1, 0); PG8_STAGE(PG8_SA(0, 1), a2 + hstepA, voffA);
            PG8_WAIT_L(8); PG8_BAR; PG8_WAIT_L(0); PG8_MMA(0, 0, At, B0); PG8_BAR; PG8_SCHED;
            PG8_LDB(B1, 1, 1); PG8_STAGE(PG8_SB(1, 0), b3, voffB);
            PG8_BAR; PG8_WAIT_L(0); PG8_MMA(0, 1, At, B1); PG8_BAR;
            PG8_LDA(At, 1, 1); PG8_STAGE(PG8_SA(1, 0), a3, voffA);
            PG8_BAR; PG8_WAIT_L(0); PG8_MMA(1, 0, At, B0); PG8_BAR; PG8_SCHED;
            PG8_STAGE(PG8_SB(1, 1), b3 + hstepB, voffB);
            PG8_WAIT_V(6); PG8_BAR; PG8_MMA(1, 1, At, B1); PG8_BAR;
            }
        }
        if constexpr (FAST && PG8_ALIGN) { if (wr == 0) PG8_BAR; }
        if (cur.kb < 0) E(acc, cur, wr, wc, fr, fq); else ES(acc, cur, wr, wc, fr, fq);
        if (Epi::DOUBLE) { asm volatile("" ::: "memory"); if (cur.kb < 0) E(acc, cur, wr, wc, fr, fq); else ES(acc, cur, wr, wc, fr, fq); }
        if (!has_next) break;
#pragma unroll
        for (int a = 0; a < 2; ++a)
#pragma unroll
            for (int b = 0; b < 2; ++b)
#pragma unroll
                for (int m = 0; m < 4; ++m)
#pragma unroll
                    for (int n = 0; n < 2; ++n) acc[a][b][m][n] = (f32x4){0.f, 0.f, 0.f, 0.f};
        cur = nxt; cA = nA; cB = nB; ++ui;
        if constexpr (FAST && PG8_ALIGN) { if (wr == 1) PG8_BAR; }
    }
    PG8_WAIT_V(0);
    if constexpr (!(FAST && PG8_ALIGN)) { if (wr == 0) PG8_BAR; }
    PG8_BAR;
#undef PG8_SA
#undef PG8_SB
#undef PG8_STAGE
#undef PG8_LDA
#undef PG8_LDB
#undef PG8_MMA
#undef PG8_WAIT_V
#undef PG8_WAIT_L
#undef PG8_BAR
#undef PG8_SCHED
}
}
using pg8::Unit;

typedef f32x4 AccT[2][2][4][2];

struct EpiProj {
    static constexpr bool PERM = true, DOUBLE = (REPEAT_PHASE == 50);
    bf16_t *P, *Q, *Kb, *V, *O, *GA, *GB;
    __device__ __forceinline__ void operator()(const AccT& acc, const Unit& u, int wr, int wc, int fr, int fq) const {
        bf16_t* base; int ldc, colt;
        if (u.pn < 4) { base = P; ldc = PW; colt = u.pn * 256; }
        else { const int t = (u.pn - 4) >> 3; colt = ((u.pn - 4) & 7) * 256; ldc = D;
            base = t == 0 ? Q : t == 1 ? Kb : t == 2 ? V : t == 3 ? O : t == 4 ? GA : GB; }
        const int row0 = u.pm * 256 + wr * 64 + fr, col0 = colt + wc * 32 + 8 * fq;
#pragma unroll
        for (int ai = 0; ai < 2; ++ai)
#pragma unroll
            for (int m = 0; m < 4; ++m) { bf16_t* rowp = base + (size_t)(row0 + ai * 128 + m * 16) * ldc + col0;
#pragma unroll
                for (int bj = 0; bj < 2; ++bj) { const f32x4 v0 = acc[ai][bj][m][0], v1 = acc[ai][bj][m][1];
                    u32x4 w; w.x = cvt_pk_bf16(v0[0], v0[1]); w.y = cvt_pk_bf16(v0[2], v0[3]); w.z = cvt_pk_bf16(v1[0], v1[1]); w.w = cvt_pk_bf16(v1[2], v1[3]);
                    *(u32x4*)(rowp + bj * 128) = w; } }
    }
};
struct EpiPool {
    static constexpr bool PERM = true; static constexpr bool DOUBLE = false;
    bf16_t* O; const float* scale;
    __device__ __forceinline__ void operator()(const AccT& acc, const Unit& u, int wr, int wc, int fr, int fq) const {
        const int row0 = u.pm * 256 + wr * 64 + fr, col0 = u.pn * 256 + wc * 32 + 8 * fq;
#pragma unroll
        for (int bj = 0; bj < 2; ++bj) { const f32x4 s0 = *(const f32x4*)(scale + col0 + bj * 128), s1 = *(const f32x4*)(scale + col0 + bj * 128 + 4);
#pragma unroll
            for (int ai = 0; ai < 2; ++ai)
#pragma unroll
                for (int m = 0; m < 4; ++m) { const f32x4 v0 = acc[ai][bj][m][0] * s0, v1 = acc[ai][bj][m][1] * s1;
                    u32x4 w; w.x = cvt_pk_bf16(v0[0], v0[1]); w.y = cvt_pk_bf16(v0[2], v0[3]); w.z = cvt_pk_bf16(v1[0], v1[1]); w.w = cvt_pk_bf16(v1[2], v1[3]);
                    *(u32x4*)(O + (size_t)(row0 + ai * 128 + m * 16) * PW + col0 + bj * 128) = w; } }
    }
};
template <int SECOND> struct EpiMerge {
    static constexpr bool PERM = true; static constexpr bool DOUBLE = false;
    const bf16_t* G; const bf16_t* Tin; bf16_t* Out;
    __device__ __forceinline__ void operator()(const AccT& acc, const Unit& u, int wr, int wc, int fr, int fq) const {
        const int row0 = u.pm * 256 + wr * 64 + fr, col0 = u.pn * 256 + wc * 32 + 8 * fq;
#pragma unroll
        for (int ai = 0; ai < 2; ++ai) {
            u32x4 gv[4][2], tv[4][2];
#pragma unroll
            for (int m = 0; m < 4; ++m)
#pragma unroll
                for (int bj = 0; bj < 2; ++bj) { const size_t off = (size_t)(row0 + ai * 128 + m * 16) * D + col0 + bj * 128;
                    gv[m][bj] = *(const u32x4*)(G + off); if (SECOND) tv[m][bj] = *(const u32x4*)(Tin + off); }
#pragma unroll
            for (int m = 0; m < 4; ++m)
#pragma unroll
                for (int bj = 0; bj < 2; ++bj) { const size_t off = (size_t)(row0 + ai * 128 + m * 16) * D + col0 + bj * 128;
                    const u32x4 g4 = gv[m][bj]; const f32x4 v0 = acc[ai][bj][m][0], v1 = acc[ai][bj][m][1];
                    float o[8];
                    o[0] = sigmoidf_(bf_lo(g4.x)) * v0[0]; o[1] = sigmoidf_(bf_hi(g4.x)) * v0[1]; o[2] = sigmoidf_(bf_lo(g4.y)) * v0[2]; o[3] = sigmoidf_(bf_hi(g4.y)) * v0[3];
                    o[4] = sigmoidf_(bf_lo(g4.z)) * v1[0]; o[5] = sigmoidf_(bf_hi(g4.z)) * v1[1]; o[6] = sigmoidf_(bf_lo(g4.w)) * v1[2]; o[7] = sigmoidf_(bf_hi(g4.w)) * v1[3];
                    if (SECOND) { const u32x4 t4 = tv[m][bj];
                        o[0] += bf_lo(t4.x); o[1] += bf_hi(t4.x); o[2] += bf_lo(t4.y); o[3] += bf_hi(t4.y); o[4] += bf_lo(t4.z); o[5] += bf_hi(t4.z); o[6] += bf_lo(t4.w); o[7] += bf_hi(t4.w); }
                    u32x4 w; w.x = cvt_pk_bf16(o[0], o[1]); w.y = cvt_pk_bf16(o[2], o[3]); w.z = cvt_pk_bf16(o[4], o[5]); w.w = cvt_pk_bf16(o[6], o[7]);
                    *(u32x4*)(Out + off) = w; }
        }
    }
};
template <int SECOND> struct EpiRes {
    static constexpr bool PERM = true; static constexpr bool DOUBLE = false;
    const float* xp; const float* xs; const bf16_t* xb; const float* gate; bf16_t* Xout;
    __device__ __forceinline__ void operator()(const AccT& acc, const Unit& u, int wr, int wc, int fr, int fq) const {
        const int row0 = u.pm * 256 + wr * 64 + fr, col0 = u.pn * 256 + wc * 32 + 8 * fq;
        const bool uni = u.pm < MP / 256;
        f32x4 gu[2][2];
        { const float* gp = gate + (size_t)(uni ? (u.pm >> 3) : 0) * MODW + col0;
#pragma unroll
          for (int bj = 0; bj < 2; ++bj)
#pragma unroll
            for (int n = 0; n < 2; ++n) gu[bj][n] = *(const f32x4*)(gp + bj * 128 + n * 4); }
#pragma unroll
        for (int ai = 0; ai < 2; ++ai)
#pragma unroll
        for (int mh = 0; mh < 2; ++mh) {
            f32x4 xv[2][2][2];
#pragma unroll
            for (int m2 = 0; m2 < 2; ++m2) { const int m = mh * 2 + m2; const int r = row0 + ai * 128 + m * 16;
                if (SECOND) {
#pragma unroll
                    for (int bj = 0; bj < 2; ++bj) { const u32x4 w = *(const u32x4*)(xb + (size_t)r * D + col0 + bj * 128);
                        xv[m2][bj][0] = (f32x4){bf_lo(w.x), bf_hi(w.x), bf_lo(w.y), bf_hi(w.y)}; xv[m2][bj][1] = (f32x4){bf_lo(w.z), bf_hi(w.z), bf_lo(w.w), bf_hi(w.w)}; }
                } else { const float* src = (r < MP ? xp + (size_t)r * D : xs + (size_t)(r - MP) * D) + col0;
#pragma unroll
                    for (int bj = 0; bj < 2; ++bj)
#pragma unroll
                        for (int n = 0; n < 2; ++n) xv[m2][bj][n] = *(const f32x4*)(src + bj * 128 + n * 4); } }
#pragma unroll
            for (int m2 = 0; m2 < 2; ++m2) { const int m = mh * 2 + m2; const int r = row0 + ai * 128 + m * 16; bf16_t* op = Xout + (size_t)r * D + col0;
                const float* gp = gate + (size_t)cond_of_row(r) * MODW + col0;
#pragma unroll
                for (int bj = 0; bj < 2; ++bj) { const f32x4 g0 = uni ? gu[bj][0] : *(const f32x4*)(gp + bj * 128), g1 = uni ? gu[bj][1] : *(const f32x4*)(gp + bj * 128 + 4);
                    const f32x4 o0 = xv[m2][bj][0] * ALPHA + g0 * acc[ai][bj][m][0], o1 = xv[m2][bj][1] * ALPHA + g1 * acc[ai][bj][m][1];
                    u32x4 w; w.x = cvt_pk_bf16(o0[0], o0[1]); w.y = cvt_pk_bf16(o0[2], o0[3]); w.z = cvt_pk_bf16(o1[0], o1[1]); w.w = cvt_pk_bf16(o1[2], o1[3]);
                    *(u32x4*)(op + bj * 128) = w; } }
        }
    }
};
struct EpiPartial {
    static constexpr bool PERM = true; static constexpr bool DOUBLE = false;
    float* part;
    __device__ __forceinline__ void operator()(const AccT& acc, const Unit& u, int wr, int wc, int fr, int fq) const {
        const int row0 = (u.pm - MP / 256) * 256 + wr * 64 + fr, col0 = u.pn * 256 + wc * 32 + 8 * fq;
        float* base = part + (size_t)u.kb * MS * D;
#pragma unroll
        for (int ai = 0; ai < 2; ++ai)
#pragma unroll
            for (int m = 0; m < 4; ++m) { float* rowp = base + (size_t)(row0 + ai * 128 + m * 16) * D + col0;
#pragma unroll
                for (int bj = 0; bj < 2; ++bj) { *(f32x4*)(rowp + bj * 128) = acc[ai][bj][m][0]; *(f32x4*)(rowp + bj * 128 + 4) = acc[ai][bj][m][1]; } }
    }
};
struct EpiSwiglu {
    static constexpr bool PERM = true; static constexpr bool DOUBLE = false;
    bf16_t* HM;
    __device__ __forceinline__ void operator()(const AccT& acc, const Unit& u, int wr, int wc, int fr, int fq) const {
        const int row0 = u.pm * 256 + wr * 64 + fr, col0 = u.pn * 128 + wc * 32 + 8 * fq;
#pragma unroll
        for (int ai = 0; ai < 2; ++ai)
#pragma unroll
            for (int m = 0; m < 4; ++m) { float o[8];
#pragma unroll
                for (int n = 0; n < 2; ++n)
#pragma unroll
                    for (int j = 0; j < 4; ++j) { const float gt = acc[ai][0][m][n][j], up = acc[ai][1][m][n][j]; o[n * 4 + j] = gt * sigmoidf_(gt) * up; }
                u32x4 w; w.x = cvt_pk_bf16(o[0], o[1]); w.y = cvt_pk_bf16(o[2], o[3]); w.z = cvt_pk_bf16(o[4], o[5]); w.w = cvt_pk_bf16(o[6], o[7]);
                *(u32x4*)(HM + (size_t)(row0 + ai * 128 + m * 16) * DFF + col0) = w; }
    }
};

#define XB_TMO      128
#define XB_XCNT(j)  (256  + 64 * (j))
#define XB_XSUB(j)  (1280 + 64 * (j))
#define XB_XGEN(j)  (2304 + 64 * (j))
#define XB_TOP      3328
#define XB_TOPGEN   3392
#define XCD_BAR_WORDS 3456
#define XB_SPIN_CAP (1u << 18)
__device__ __forceinline__ unsigned xb_ld(unsigned* p)              { return __hip_atomic_load(p, __ATOMIC_RELAXED, __HIP_MEMORY_SCOPE_AGENT); }
__device__ __forceinline__ unsigned xb_add(unsigned* p, unsigned v) { return __hip_atomic_fetch_add(p, v, __ATOMIC_RELAXED, __HIP_MEMORY_SCOPE_AGENT); }
__device__ __forceinline__ unsigned xb_xcc_id() { return (unsigned)__builtin_amdgcn_s_getreg((3 << 11) | 20) & 0xFu; }
#define XB_SPIN(cond, bar) do { unsigned _sp = 0; while (cond) { __builtin_amdgcn_s_sleep(1); \
    if ((++_sp & 255u) == 0u) { if (xb_ld(&(bar)[XB_TMO])) break; if (_sp > XB_SPIN_CAP) { atomicAdd(&(bar)[XB_TMO], 1u); break; } } } } while (0)
struct XcdBarrier { unsigned* bar; unsigned x; volatile LAS unsigned* st; };
__device__ __forceinline__ XcdBarrier xcd_barrier_post(unsigned* bar, volatile LAS unsigned* st) {
    XcdBarrier b; b.bar = bar; b.x = xb_xcc_id(); b.st = st;
    if (threadIdx.x == 0) (void)xb_add(&bar[XB_XCNT(b.x)], 1u);
    return b;
}
__device__ __forceinline__ void xcd_barrier_complete(unsigned* bar, unsigned x, unsigned& nloc, unsigned& nx) {
    const unsigned G = gridDim.x * gridDim.y * gridDim.z;
    unsigned sum, cnt, mine, sp = 0u;
    for (;;) {
        sum = 0u; cnt = 0u; mine = 0u;
#pragma unroll
        for (unsigned j = 0; j < 16; ++j) { const unsigned c = xb_ld(&bar[XB_XCNT(j)]); sum += c; cnt += (c > 0u) ? 1u : 0u; mine = (j == x) ? c : mine; }
        if (sum == G) break;
        __builtin_amdgcn_s_sleep(1);
        if ((++sp & 255u) == 0u) { if (xb_ld(&bar[XB_TMO])) break; if (sp > XB_SPIN_CAP) { atomicAdd(&bar[XB_TMO], 1u); break; } }
    }
    nloc = mine > 0u ? mine : 1u; nx = cnt > 0u ? cnt : 1u;
}
__device__ __forceinline__ void xcd_barrier(const XcdBarrier& b) {
    asm volatile("s_waitcnt vmcnt(0)" ::: "memory");
    __syncthreads();
    if (threadIdx.x == 0) {
        unsigned* bar = b.bar;
        __builtin_amdgcn_s_waitcnt(0);
        unsigned nloc = b.st[0], nx = b.st[1];
        if (nloc == 0u) { xcd_barrier_complete(bar, b.x, nloc, nx); b.st[0] = nloc; b.st[1] = nx; }
        const unsigned old = xb_add(&bar[XB_XSUB(b.x)], 1u);
        const unsigned gen = old / nloc;
        if (old + 1u == (gen + 1u) * nloc) {
            __builtin_amdgcn_fence(__ATOMIC_RELEASE, "agent");
            asm volatile("s_waitcnt vmcnt(0)" ::: "memory");
            const unsigned og = xb_add(&bar[XB_TOP], 1u);
            const unsigned tg = og / nx;
            if (og + 1u == (tg + 1u) * nx) xb_add(&bar[XB_TOPGEN], 1u);
            else XB_SPIN(xb_ld(&bar[XB_TOPGEN]) == tg, bar);
            __builtin_amdgcn_fence(__ATOMIC_ACQUIRE, "agent");
            xb_add(&bar[XB_XGEN(b.x)], 1u);
            asm volatile("s_waitcnt vmcnt(0)" ::: "memory");
        } else {
            XB_SPIN(xb_ld(&bar[XB_XGEN(b.x)]) == gen, bar);
            __builtin_amdgcn_fence(__ATOMIC_ACQUIRE, "agent");
            asm volatile("s_waitcnt vmcnt(0)" ::: "memory");
        }
    }
    __syncthreads();
}

struct KArgs { const float* in[26]; float* out; unsigned char* ws; int ph_lo, ph_hi; };

struct Frame {
    LAS unsigned char* lds;
    const float* const* in; float* out; unsigned char* ws;
    int tid, lane, wid, G, bid;
};

__device__ __forceinline__ void transpose_tile(LAS float* tile, const float* src, int ldsrc, int k0, int c0, bf16_t* dst, int K, int n0, int tid) {
    { const int i = tid >> 3, j8 = (tid & 7) * 8; const float* sp = src + (size_t)(k0 + i) * ldsrc + c0 + j8;
      const f32x4 a = *(const f32x4*)sp, b = *(const f32x4*)(sp + 4); LAS float* tp = tile + i * 65 + j8;
      tp[0] = a[0]; tp[1] = a[1]; tp[2] = a[2]; tp[3] = a[3]; tp[4] = b[0]; tp[5] = b[1]; tp[6] = b[2]; tp[7] = b[3]; }
    __syncthreads();
    { const int n = tid >> 3, k8 = (tid & 7) * 8; const LAS float* tp = tile + k8 * 65 + n;
      u32x4 w; w.x = cvt_pk_bf16(tp[0], tp[65]); w.y = cvt_pk_bf16(tp[130], tp[195]); w.z = cvt_pk_bf16(tp[260], tp[325]); w.w = cvt_pk_bf16(tp[390], tp[455]);
      *(u32x4*)(dst + (size_t)(n0 + n) * K + k0 + k8) = w; }
    __syncthreads();
}

__device__ __forceinline__ void phase_prologue(const Frame& F) {
    const int tid = F.tid;
    REP(40) {
        LAS float* sT = (LAS float*)F.lds;
        LAS float* red = (LAS float*)(F.lds + 53248);
        float* MOD = (float*)(F.ws + WS_MOD);
        const float* cp = F.in[2]; const float* cs = F.in[3]; const float* wada = F.in[8]; const float* bada = F.in[9];
        const int cgp = tid % 12, cdg = (tid / 12) % 4, kl = tid / 48;
        for (int cb = F.bid; cb < 256; cb += F.G) {
            typedef float f32x2 __attribute__((ext_vector_type(2)));
            f32x2 acc[12][2];
#pragma unroll
            for (int c = 0; c < 12; ++c) { acc[c][0] = (f32x2){0.f, 0.f}; acc[c][1] = (f32x2){0.f, 0.f}; }
            for (int kc = 0; kc < 8; ++kc) {
                __syncthreads();
                for (int i = 0; i < 24; ++i) { const int idx = tid + 512 * i, cd = idx >> 8, kk = idx & 255;
                    const float cv = cd < 16 ? cp[cd * D + kc * 256 + kk] : cs[(cd - 16) * D + kc * 256 + kk];
                    sT[kk * 52 + cd] = cv * sigmoidf_(cv); }
                __syncthreads();
                if (tid < 480) {
#pragma unroll 2
                    for (int kk = kl; kk < 256; kk += 10) {
                        const f32x4 w4 = *(const f32x4*)(wada + (size_t)(kc * 256 + kk) * MODW + 48 * cb + 4 * cgp);
                        const f32x2 w01 = (f32x2){w4[0], w4[1]}, w23 = (f32x2){w4[2], w4[3]};
                        const LAS f32x4* sp = (const LAS f32x4*)(sT + kk * 52 + 12 * cdg);
                        const f32x4 s0 = sp[0], s1 = sp[1], s2 = sp[2];
#pragma unroll
                        for (int c = 0; c < 4; ++c) {
                            acc[c][0] = __builtin_elementwise_fma((f32x2){s0[c], s0[c]}, w01, acc[c][0]); acc[c][1] = __builtin_elementwise_fma((f32x2){s0[c], s0[c]}, w23, acc[c][1]);
                            acc[4 + c][0] = __builtin_elementwise_fma((f32x2){s1[c], s1[c]}, w01, acc[4 + c][0]); acc[4 + c][1] = __builtin_elementwise_fma((f32x2){s1[c], s1[c]}, w23, acc[4 + c][1]);
                            acc[8 + c][0] = __builtin_elementwise_fma((f32x2){s2[c], s2[c]}, w01, acc[8 + c][0]); acc[8 + c][1] = __builtin_elementwise_fma((f32x2){s2[c], s2[c]}, w23, acc[8 + c][1]); }
                    }
                }
            }
            if (tid < 480) {
#pragma unroll
                for (int c = 0; c < 12; ++c) *(LAS f32x4*)(red + (kl * 48 + 12 * cdg + c) * 48 + 4 * cgp) = (f32x4){acc[c][0][0], acc[c][0][1], acc[c][1][0], acc[c][1][1]};
            }
            __syncthreads();
            for (int o = tid; o < 2304; o += 512) { const int cd = o / 48, col = o % 48; float s = bada[48 * cb + col];
#pragma unroll
                for (int k = 0; k < 10; ++k) s += red[(k * 48 + cd) * 48 + col];
                MOD[(size_t)cd * MODW + 48 * cb + col] = s; }
            __syncthreads();
        }
    }
    REP(41) {
        LAS float* tile = (LAS float*)F.lds;
        constexpr int T0 = 32 * 208, T1 = T0 + 64, T2 = T1 + 512, T3 = T2 + 1024, T4 = T3 + 1024, T5 = T4 + 32 * 176, T6 = T5 + 88 * 32;
        const int i = tid >> 3, j8 = (tid & 7) * 8;
        for (int Tb = F.bid * 4; Tb < T6; Tb += F.G * 4) {
            const float* src[4]; bf16_t* dst[4]; bool ok[4]; f32x4 va[4], vb[4];
#pragma unroll
            for (int q = 0; q < 4; ++q) { const int T = Tb + q; ok[q] = T < T6;
                const float* sp; int ldsrc, k0, c0, K, n0; bf16_t* dp;
                if (T < T0) { const int nt = T % 208, kt = T / 208; n0 = nt * 64; c0 = n0 < 9216 ? n0 : n0 + 16; sp = F.in[10]; ldsrc = NIN; k0 = kt * 64; dp = (bf16_t*)(F.ws + WS_WIN); K = D; }
                else if (T < T1) { const int t = T - T0, g = t >> 4, kt = (t >> 2) & 3, nt = t & 3; sp = F.in[13] + (size_t)g * 65536; ldsrc = 256; k0 = kt * 64; c0 = nt * 64; dp = (bf16_t*)(F.ws + WS_WPOOL) + (size_t)g * 65536; K = 256; n0 = nt * 64; }
                else if (T < T2) { const int t = T - T1, nt = t & 31, kt = t >> 5; sp = F.in[16]; ldsrc = D; k0 = kt * 64; c0 = nt * 64; dp = (bf16_t*)(F.ws + WS_WPA); K = PW; n0 = nt * 64; }
                else if (T < T3) { const int t = T - T2, nt = t & 31, kt = t >> 5; sp = F.in[17]; ldsrc = D; k0 = kt * 64; c0 = nt * 64; dp = (bf16_t*)(F.ws + WS_WPB); K = D; n0 = nt * 64; }
                else if (T < T4) { const int t = T - T3, nt = t & 31, kt = t >> 5; sp = F.in[18]; ldsrc = D; k0 = kt * 64; c0 = nt * 64; dp = (bf16_t*)(F.ws + WS_WOUT); K = D; n0 = nt * 64; }
                else if (T < T5) { const int t = T - T4, nt = t % 176, kt = t / 176; const int pn = nt >> 2, qq = nt & 3; sp = qq < 2 ? F.in[21] : F.in[22]; ldsrc = DFF; k0 = kt * 64; c0 = 128 * pn + 64 * (qq & 1); dp = (bf16_t*)(F.ws + WS_WGU); K = D; n0 = nt * 64; }
                else { const int t = (ok[q] ? T : T6 - 1) - T5, nt = t & 31, kt = t >> 5; sp = F.in[23]; ldsrc = D; k0 = kt * 64; c0 = nt * 64; dp = (bf16_t*)(F.ws + WS_WDOWN); K = DFF; n0 = nt * 64; }
                src[q] = sp + (size_t)(k0 + i) * ldsrc + c0 + j8;
                dst[q] = dp + (size_t)(n0 + i) * K + k0 + j8;
                va[q] = *(const f32x4*)src[q]; vb[q] = *(const f32x4*)(src[q] + 4); }
#pragma unroll
            for (int q = 0; q < 4; ++q) { LAS float* tp = tile + q * (64 * 65) + i * 65 + j8;
                tp[0] = va[q][0]; tp[1] = va[q][1]; tp[2] = va[q][2]; tp[3] = va[q][3]; tp[4] = vb[q][0]; tp[5] = vb[q][1]; tp[6] = vb[q][2]; tp[7] = vb[q][3]; }
            __syncthreads();
#pragma unroll
            for (int q = 0; q < 4; ++q) { const LAS float* tp = tile + q * (64 * 65) + j8 * 65 + i;
                u32x4 w; w.x = cvt_pk_bf16(tp[0], tp[65]); w.y = cvt_pk_bf16(tp[130], tp[195]); w.z = cvt_pk_bf16(tp[260], tp[325]); w.w = cvt_pk_bf16(tp[390], tp[455]);
                if (ok[q]) *(u32x4*)dst[q] = w; }
            __syncthreads();
        }
    }
}

__device__ __forceinline__ void phase_ln_in(const Frame& F) {
    LAS float* wgT = (LAS float*)F.lds;
    const float* win = F.in[10];
    for (int k = F.tid; k < D; k += NTHREADS) { const float* sp = win + (size_t)k * NIN + 9216;
#pragma unroll
        for (int q = 0; q < 4; ++q) { const f32x4 v = *(const f32x4*)(sp + 4 * q); wgT[(4 * q + 0) * D + k] = v[0]; wgT[(4 * q + 1) * D + k] = v[1]; wgT[(4 * q + 2) * D + k] = v[2]; wgT[(4 * q + 3) * D + k] = v[3]; } }
    __syncthreads();
    const float* MOD = (const float*)(F.ws + WS_MOD); float* GATES = (float*)(F.ws + WS_GATES); bf16_t* U = (bf16_t*)(F.ws + WS_U);
    const int lane = F.lane;
    const int gidx = ((lane >> 5) & 1) * 8 + ((lane >> 4) & 1) * 4 + ((lane >> 3) & 1) * 2 + ((lane >> 2) & 1);
    const float bias = gidx < 8 ? F.in[11][gidx] : F.in[12][gidx - 8];
    const bool b5 = (lane & 32) != 0, b4 = (lane & 16) != 0, b3 = (lane & 8) != 0, b2 = (lane & 4) != 0;
    for (int r = F.bid * 8 + F.wid; r < M; r += F.G * 8) {
        const float* xr = r < MP ? F.in[0] + (size_t)r * D : F.in[1] + (size_t)(r - MP) * D; const int cd = cond_of_row(r);
        f32x4 xv[8]; float s = 0.f;
#pragma unroll
        for (int j = 0; j < 8; ++j) { xv[j] = *(const f32x4*)(xr + j * 256 + lane * 4); s += (xv[j][0] + xv[j][1]) + (xv[j][2] + xv[j][3]); }
        const float mu = wave_sum(s) * (1.0f / D); float q = 0.f;
#pragma unroll
        for (int j = 0; j < 8; ++j) { xv[j] = xv[j] - mu; q += (xv[j][0] * xv[j][0] + xv[j][1] * xv[j][1]) + (xv[j][2] * xv[j][2] + xv[j][3] * xv[j][3]); }
        const float rstd = rsqrtf(wave_sum(q) * (1.0f / D) + LN_EPS);
        const float* sh = MOD + (size_t)cd * MODW; const float* sc = sh + D;
        typedef float f32x2 __attribute__((ext_vector_type(2)));
        f32x2 ga2[16];
#pragma unroll
        for (int g = 0; g < 16; ++g) ga2[g] = (f32x2){0.f, 0.f};
#pragma unroll
        for (int j = 0; j < 8; ++j) { const int e = j * 256 + lane * 4; const f32x4 scv = *(const f32x4*)(sc + e), shv = *(const f32x4*)(sh + e);
            const f32x4 u = xv[j] * rstd * (scv + 1.0f) + shv;
            u32x2 w; w.x = cvt_pk_bf16(u[0], u[1]); w.y = cvt_pk_bf16(u[2], u[3]); *(u32x2*)(U + (size_t)r * D + e) = w;
            const f32x2 u01 = (f32x2){u[0], u[1]}, u23 = (f32x2){u[2], u[3]};
#pragma unroll
            for (int g = 0; g < 16; ++g) { const f32x4 wv = *(const LAS f32x4*)(wgT + g * D + e);
                ga2[g] = __builtin_elementwise_fma(u01, (f32x2){wv[0], wv[1]}, ga2[g]); ga2[g] = __builtin_elementwise_fma(u23, (f32x2){wv[2], wv[3]}, ga2[g]); } }
        float ga[16];
#pragma unroll
        for (int g = 0; g < 16; ++g) ga[g] = ga2[g][0] + ga2[g][1];
        float v8[8], v4[4], v2[2];
#pragma unroll
        for (int i = 0; i < 8; ++i) { const float mine = b5 ? ga[i + 8] : ga[i], oth = b5 ? ga[i] : ga[i + 8]; v8[i] = mine + __shfl_xor(oth, 32); }
#pragma unroll
        for (int i = 0; i < 4; ++i) { const float mine = b4 ? v8[i + 4] : v8[i], oth = b4 ? v8[i] : v8[i + 4]; v4[i] = mine + __shfl_xor(oth, 16); }
#pragma unroll
        for (int i = 0; i < 2; ++i) { const float mine = b3 ? v4[i + 2] : v4[i], oth = b3 ? v4[i] : v4[i + 2]; v2[i] = mine + __shfl_xor(oth, 8); }
        float v1 = (b2 ? v2[1] : v2[0]) + __shfl_xor(b2 ? v2[0] : v2[1], 4);
        v1 += __shfl_xor(v1, 2); v1 += __shfl_xor(v1, 1);
        if ((lane & 3) == 0) GATES[(size_t)r * 16 + gidx] = v1 + bias;
    }
    __syncthreads();
}

__device__ __forceinline__ void acc_bf8(float (&sum)[8], const u32x4 v) {
    sum[0] += bf_lo(v.x); sum[1] += bf_hi(v.x); sum[2] += bf_lo(v.y); sum[3] += bf_hi(v.y); sum[4] += bf_lo(v.z); sum[5] += bf_hi(v.z); sum[6] += bf_lo(v.w); sum[7] += bf_hi(v.w);
}
template <int W> __device__ __forceinline__ void pool_group(const Frame& F, int g) {
    const bf16_t* P = (const bf16_t*)((unsigned char*)F.out + SZ_TOK); bf16_t* Y = (bf16_t*)((unsigned char*)F.out + SZ_TOK + (size_t)M * PW * 2);
    const float* spool = F.in[4];
    for (int idx = F.bid * NTHREADS + F.tid; idx < M * 32; idx += F.G * NTHREADS) {
        const int r = idx >> 5, c = g * 256 + (idx & 31) * 8;
        const bool prompt = r < MP; const int b = prompt ? (r >> 11) : ((r - MP) >> 5), l = prompt ? (r & 2047) : ((r - MP) & 31);
        float sum[8], tok[8];
        const bf16_t* pr = P + (size_t)r * PW + c;
        u32x4 v[W];
#pragma unroll
        for (int j = 0; j < W; ++j) v[j] = (l - j >= 0) ? *(const u32x4*)(pr - (size_t)j * PW) : (u32x4){0u, 0u, 0u, 0u};
        tok[0] = bf_lo(v[0].x); tok[1] = bf_hi(v[0].x); tok[2] = bf_lo(v[0].y); tok[3] = bf_hi(v[0].y); tok[4] = bf_lo(v[0].z); tok[5] = bf_hi(v[0].z); tok[6] = bf_lo(v[0].w); tok[7] = bf_hi(v[0].w);
#pragma unroll
        for (int q = 0; q < 8; ++q) sum[q] = tok[q];
#pragma unroll
        for (int j = 1; j < W; ++j) acc_bf8(sum, v[j]);
        if (!prompt && l < W - 1) {
            for (int j = l + 1; j < W; ++j) { const float* sp = spool + ((size_t)b * 15 + 15 + (l - j)) * PW + c; const f32x4 x0 = *(const f32x4*)sp, x1 = *(const f32x4*)(sp + 4);
                sum[0] += x0[0]; sum[1] += x0[1]; sum[2] += x0[2]; sum[3] += x0[3]; sum[4] += x1[0]; sum[5] += x1[1]; sum[6] += x1[2]; sum[7] += x1[3]; } }
        const float inv = 1.0f / (float)(prompt ? (l + 1 < W ? l + 1 : W) : W);
        u32x4 o; o.x = cvt_pk_bf16(sum[0] * inv - tok[0], sum[1] * inv - tok[1]); o.y = cvt_pk_bf16(sum[2] * inv - tok[2], sum[3] * inv - tok[3]);
        o.z = cvt_pk_bf16(sum[4] * inv - tok[4], sum[5] * inv - tok[5]); o.w = cvt_pk_bf16(sum[6] * inv - tok[6], sum[7] * inv - tok[7]);
        *(u32x4*)(Y + (size_t)r * PW + c) = o;
        float* sp = nullptr;
        if (prompt && l >= SEQ - 15) sp = F.out + OUT_POOLP + ((size_t)b * 15 + (l - (SEQ - 15))) * PW + c;
        if (!prompt && l >= DSEQ - 15) sp = F.out + OUT_POOLS + ((size_t)b * 15 + (l - (DSEQ - 15))) * PW + c;
        if (sp) { *(f32x4*)sp = (f32x4){tok[0], tok[1], tok[2], tok[3]}; *(f32x4*)(sp + 4) = (f32x4){tok[4], tok[5], tok[6], tok[7]}; }
    }
}
__device__ __forceinline__ void phase_pool(const Frame& F) { pool_group<2>(F, 0); pool_group<4>(F, 1); pool_group<8>(F, 2); pool_group<16>(F, 3); }

template <int CTRL, int ROW_MASK> __device__ __forceinline__ float dpp_f(float old, float src) {
    return __int_as_float(__builtin_amdgcn_update_dpp(__float_as_int(old), __float_as_int(src), CTRL, ROW_MASK, 0xF, false));
}
__device__ __forceinline__ float row16_sum(float v) {
    v += dpp_f<0xB1, 0xF>(v, v); v += dpp_f<0x4E, 0xF>(v, v); v += dpp_f<0x141, 0xF>(v, v); v += dpp_f<0x140, 0xF>(v, v); return v;
}
__device__ __forceinline__ float oct_sum(float v) {
    v += dpp_f<0xB1, 0xF>(v, v); v += dpp_f<0x4E, 0xF>(v, v); v += dpp_f<0x141, 0xF>(v, v); return v;
}
__device__ __forceinline__ float wave_incl_sum(float v, int) {
    v += dpp_f<0x111, 0xF>(0.f, v); v += dpp_f<0x112, 0xF>(0.f, v); v += dpp_f<0x114, 0xF>(0.f, v); v += dpp_f<0x118, 0xF>(0.f, v);
    v += dpp_f<0x142, 0xA>(0.f, v); v += dpp_f<0x143, 0xC>(0.f, v); return v;
}
__device__ __forceinline__ float wave_incl_max(float v, int) {
    const float ninf = -INFINITY;
    v = fmaxf(v, dpp_f<0x111, 0xF>(ninf, v)); v = fmaxf(v, dpp_f<0x112, 0xF>(ninf, v)); v = fmaxf(v, dpp_f<0x114, 0xF>(ninf, v)); v = fmaxf(v, dpp_f<0x118, 0xF>(ninf, v));
    v = fmaxf(v, dpp_f<0x142, 0xA>(ninf, v)); v = fmaxf(v, dpp_f<0x143, 0xC>(ninf, v)); return v;
}

#define MLSTM_LOAD(stp) do { const size_t rb_ = (size_t)(row0 + (stp) * 64); \
    const bf16_t* qrow_ = Qb + rb_ * D + h * HD; const bf16_t* krow_ = Kb + rb_ * D + h * HD; const bf16_t* vrow_ = Vb + rb_ * D + h * HD + eh * 128; const float* grow_ = GATES + rb_ * 16 + h; \
    _Pragma("unroll") for (int i_ = 0; i_ < 4; ++i_) { \
        if ((int)(offqk[i_] >> 11) < L) { qreg[i_] = *(const u32x4*)(qrow_ + offqk[i_]); kreg[i_] = *(const u32x4*)(krow_ + offqk[i_]); } \
        else { qreg[i_] = (u32x4){0u, 0u, 0u, 0u}; kreg[i_] = (u32x4){0u, 0u, 0u, 0u}; } } \
    _Pragma("unroll") for (int i_ = 0; i_ < 2; ++i_) { \
        if (lane < L) vreg[i_] = *(const u32x4*)(vrow_ + offv + i_ * 8); else vreg[i_] = (u32x4){0u, 0u, 0u, 0u}; } \
    if (lane < L) { igr = grow_[lane * 16]; fgr = grow_[lane * 16 + 8]; } else { igr = -INFINITY; fgr = 0.f; } } while (0)

__device__ __forceinline__ void mlstm_item(LAS unsigned char* lds, const bf16_t* Qb, const bf16_t* Kb, const bf16_t* Vb, bf16_t* Hb, const float* GATES,
                           int row0, int nsteps, int L, int h, int eh, const float* C0, const float* n0, float m_init,
                           float* C_out, float* n_out, float* m_out) {
    const int tid = threadIdx.x, wid = __builtin_amdgcn_readfirstlane(tid >> 6), lane = tid & 63, fr = lane & 15, fq = lane >> 4;
    constexpr int QP = 8 * 33, KP = 8 * 34, TP = 8 * 10;
    LAS bf16_t* Qs = (LAS bf16_t*)lds;
    LAS bf16_t* Ks = (LAS bf16_t*)(lds + 33792);
    LAS bf16_t* Kt = (LAS bf16_t*)(lds + 68608);
    LAS bf16_t* Vt = (LAS bf16_t*)(lds + 109568);
    LAS bf16_t* Ss = (LAS bf16_t*)(lds + 130048);
    LAS float* nS = (LAS float*)(lds + 140288);
    LAS float* rsS = (LAS float*)(lds + 142336);
    LAS float* qnS = (LAS float*)(lds + 142848);
    f32x4 Cacc[16];
    if (C0) { const float* cp = C0 + (size_t)(4 * fq) * HD + eh * 128 + 16 * wid + fr;
#pragma unroll
      for (int t = 0; t < 16; ++t) {
#pragma unroll
        for (int i = 0; i < 4; ++i) Cacc[t][i] = cp[i * HD];
        cp += 16 * HD; asm volatile("" : "+v"(cp)); } }
    else {
#pragma unroll
      for (int t = 0; t < 16; ++t) Cacc[t] = (f32x4){0.f, 0.f, 0.f, 0.f}; }
    if (tid < 256) nS[tid] = n0 ? n0[tid] : 0.f;
    float m_prev = m_init; int p = 0;
    u32x4 qreg[4], kreg[4], vreg[2]; float igr, fgr;
    unsigned offqk[4];
#pragma unroll
    for (int i = 0; i < 4; ++i) { const int pp = tid + 512 * i; offqk[i] = (unsigned)((pp >> 5) * D + (pp & 31) * 8); }
    const unsigned offv = (unsigned)(lane * D + wid * 16);
    MLSTM_LOAD(0);
    for (int st = 0; st < nsteps; ++st) {
        const int rbase = row0 + st * 64;
        const float lf = lane < L ? (fminf(fgr, 0.f) - log1pf(__expf(-fabsf(fgr)))) : 0.f;
        const float bcum = wave_incl_sum(lf, lane);
        const float gsc = igr - bcum;
        const float Mv = fmaxf(m_prev, wave_incl_max(gsc, lane));
        const float M63 = __int_as_float(__builtin_amdgcn_readlane(__float_as_int(Mv), 63)), b63 = __int_as_float(__builtin_amdgcn_readlane(__float_as_int(bcum), 63));
        const float wsv = __expf(gsc - M63) * 0.0625f;
        const float winter = __expf(m_prev - Mv);
        const float eneg = __expf(-(bcum + Mv));
        const float decay = __expf(m_prev - M63);
        const float m_new = b63 + M63;
#pragma unroll
        for (int i = 0; i < 4; ++i) { const int pp = tid + 512 * i, s = pp >> 5, c8 = (pp & 31) * 8; *(LAS u32x4*)(Qs + s * QP + c8) = qreg[i]; *(LAS u32x4*)(Ks + s * KP + c8) = kreg[i]; }
#pragma unroll
        for (int i = 0; i < 2; ++i) { const int eg = wid * 2 + i; const u32x4 v = vreg[i]; LAS bf16_t* vp = Vt + (eg * 8) * TP + lane;
            vp[0] = (bf16_t)(v.x & 0xffffu); vp[1 * TP] = (bf16_t)(v.x >> 16); vp[2 * TP] = (bf16_t)(v.y & 0xffffu); vp[3 * TP] = (bf16_t)(v.y >> 16);
            vp[4 * TP] = (bf16_t)(v.z & 0xffffu); vp[5 * TP] = (bf16_t)(v.z >> 16); vp[6 * TP] = (bf16_t)(v.w & 0xffffu); vp[7 * TP] = (bf16_t)(v.w >> 16); }
        __syncthreads();
#pragma unroll
        for (int i = 0; i < 4; ++i) { const int dg = wid * 4 + i; const u32x4 kv = *(const LAS u32x4*)(Ks + lane * KP + dg * 8); LAS bf16_t* kp = Kt + (dg * 8) * TP + lane;
            const unsigned w0 = cvt_pk_bf16(bf_lo(kv.x) * wsv, bf_hi(kv.x) * wsv), w1 = cvt_pk_bf16(bf_lo(kv.y) * wsv, bf_hi(kv.y) * wsv);
            const unsigned w2 = cvt_pk_bf16(bf_lo(kv.z) * wsv, bf_hi(kv.z) * wsv), w3 = cvt_pk_bf16(bf_lo(kv.w) * wsv, bf_hi(kv.w) * wsv);
            kp[0] = (bf16_t)(w0 & 0xffffu); kp[1 * TP] = (bf16_t)(w0 >> 16); kp[2 * TP] = (bf16_t)(w1 & 0xffffu); kp[3 * TP] = (bf16_t)(w1 >> 16);
            kp[4 * TP] = (bf16_t)(w2 & 0xffffu); kp[5 * TP] = (bf16_t)(w2 >> 16); kp[6 * TP] = (bf16_t)(w3 & 0xffffu); kp[7 * TP] = (bf16_t)(w3 >> 16); }
        __builtin_amdgcn_sched_barrier(0);
        REP(60) {
            const int lt = wid >> 1, st0 = (wid & 1) * 2;
            f32x4 sacc[2]; sacc[0] = (f32x4){0.f, 0.f, 0.f, 0.f}; sacc[1] = sacc[0];
#pragma unroll
            for (int hk = 0; hk < 2; ++hk) { bf16x8 af[4], bfr[4][2];
#pragma unroll
                for (int k4 = 0; k4 < 4; ++k4) { const int kk = hk * 4 + k4; af[k4] = *(const LAS bf16x8*)(Qs + (16 * lt + fr) * QP + 32 * kk + 8 * fq);
#pragma unroll
                    for (int t2 = 0; t2 < 2; ++t2) bfr[k4][t2] = *(const LAS bf16x8*)(Ks + (16 * (st0 + t2) + fr) * KP + 32 * kk + 8 * fq); }
                __builtin_amdgcn_sched_barrier(0);
#pragma unroll
                for (int k4 = 0; k4 < 4; ++k4)
#pragma unroll
                    for (int t2 = 0; t2 < 2; ++t2) sacc[t2] = mfma16(af[k4], bfr[k4][t2], sacc[t2]);
                __builtin_amdgcn_sched_barrier(0); }
            float Ml[4], rs[4];
#pragma unroll
            for (int i = 0; i < 4; ++i) { Ml[i] = __shfl(Mv, 16 * lt + 4 * fq + i); rs[i] = 0.f; }
#pragma unroll
            for (int t2 = 0; t2 < 2; ++t2) { const int s = 16 * (st0 + t2) + fr; const float gs = __shfl(gsc, s);
#pragma unroll
                for (int i = 0; i < 4; ++i) { const int l = 16 * lt + 4 * fq + i; const float val = (s <= l) ? sacc[t2][i] * 0.0625f * __expf(gs - Ml[i]) : 0.f;
                    rs[i] += val; Ss[l * TP + s] = (bf16_t)(cvt_pk_bf16(val, 0.f) & 0xffffu); } }
#pragma unroll
            for (int i = 0; i < 4; ++i) { const float v = row16_sum(rs[i]);
                if (fr == 0) rsS[(wid & 1) * 64 + 16 * lt + 4 * fq + i] = v; }
        }
        __builtin_amdgcn_sched_barrier(0);
        {
            const int l = 8 * wid + (lane >> 3), part = lane & 7; float a = 0.f;
#pragma unroll
            for (int j = 0; j < 4; ++j) { const u32x4 qv = *(const LAS u32x4*)(Qs + l * QP + 32 * part + 8 * j);
                const f32x4 n0v = *(const LAS f32x4*)(nS + p * 256 + 32 * part + 8 * j), n1v = *(const LAS f32x4*)(nS + p * 256 + 32 * part + 8 * j + 4);
                a += bf_lo(qv.x) * n0v[0] + bf_hi(qv.x) * n0v[1] + bf_lo(qv.y) * n0v[2] + bf_hi(qv.y) * n0v[3] + bf_lo(qv.z) * n1v[0] + bf_hi(qv.z) * n1v[1] + bf_lo(qv.w) * n1v[2] + bf_hi(qv.w) * n1v[3]; }
            a = oct_sum(a);
            if (part == 0) qnS[l] = a;
        }
        __builtin_amdgcn_sched_barrier(0);
        f32x4 oacc[4];
#pragma unroll
        for (int i = 0; i < 4; ++i) oacc[i] = (f32x4){0.f, 0.f, 0.f, 0.f};
        REP(61) {
            if (REPEAT_PHASE == 61) { asm volatile("" : "+v"(oacc[0]), "+v"(oacc[1]), "+v"(oacc[2]), "+v"(oacc[3]));
#pragma unroll
                for (int i = 0; i < 4; ++i) oacc[i] = (f32x4){0.f, 0.f, 0.f, 0.f}; }
            bf16x8 qf[2][4];
#define QC_LOAD(buf, kk_) do { _Pragma("unroll") for (int lt2 = 0; lt2 < 4; ++lt2) { const LAS bf16_t* qp = Qs + (16 * lt2 + fr) * QP + 32 * (kk_) + 4 * fq; \
                const LAS bf16_t* qp2 = qp + 16; asm volatile("" : "+v"(qp2));   const u32x2 q0 = *(const LAS u32x2*)qp, q1 = *(const LAS u32x2*)qp2; qf[buf][lt2] = as_bf16x8((u32x4){q0.x, q0.y, q1.x, q1.y}); } } while (0)
            QC_LOAD(0, 0);
#pragma unroll
            for (int kk = 0; kk < 8; ++kk) {
                if (kk + 1 < 8) QC_LOAD((kk + 1) & 1, kk + 1);
                u32x4 cw; cw.x = cvt_pk_bf16(Cacc[2 * kk][0], Cacc[2 * kk][1]); cw.y = cvt_pk_bf16(Cacc[2 * kk][2], Cacc[2 * kk][3]);
                cw.z = cvt_pk_bf16(Cacc[2 * kk + 1][0], Cacc[2 * kk + 1][1]); cw.w = cvt_pk_bf16(Cacc[2 * kk + 1][2], Cacc[2 * kk + 1][3]);
                const bf16x8 cf = as_bf16x8(cw);
                __builtin_amdgcn_sched_barrier(0);
#pragma unroll
                for (int lt2 = 0; lt2 < 4; ++lt2) oacc[lt2] = mfma16(cf, qf[kk & 1][lt2], oacc[lt2]);
                __builtin_amdgcn_sched_barrier(0);
            }
#undef QC_LOAD
        }
        __builtin_amdgcn_sched_barrier(0);
        if (REPEAT_PHASE == 63) { __syncthreads(); __syncthreads(); __syncthreads(); }
        if (st + 1 < nsteps) MLSTM_LOAD(st + 1);
        __syncthreads();
        bf16x8 vfr[2];
#pragma unroll
        for (int ks = 0; ks < 2; ++ks) vfr[ks] = *(const LAS bf16x8*)(Vt + (16 * wid + fr) * TP + 32 * ks + 8 * fq);
        bf16x8 sfr[4][2];
#pragma unroll
        for (int lt2 = 0; lt2 < 4; ++lt2)
#pragma unroll
            for (int ks = 0; ks < 2; ++ks) sfr[lt2][ks] = *(const LAS bf16x8*)(Ss + (16 * lt2 + fr) * TP + 32 * ks + 8 * fq);
#pragma unroll
        for (int lt2 = 0; lt2 < 4; ++lt2) { const int l = 16 * lt2 + fr; const float wl = __shfl(winter, l), en = __shfl(eneg, l);
            oacc[lt2] = oacc[lt2] * wl;
#pragma unroll
            for (int ks = 0; ks < 2; ++ks) oacc[lt2] = mfma16(vfr[ks], sfr[lt2][ks], oacc[lt2]);
            const float den = wl * qnS[l] + rsS[l] + rsS[64 + l]; const float inv = 1.0f / fmaxf(fabsf(den), en);
            if (l < L) { u32x2 w; w.x = cvt_pk_bf16(oacc[lt2][0] * inv, oacc[lt2][1] * inv); w.y = cvt_pk_bf16(oacc[lt2][2] * inv, oacc[lt2][3] * inv);
                *(u32x2*)(Hb + (size_t)(rbase + l) * D + h * HD + eh * 128 + 16 * wid + 4 * fq) = w; } }
        __builtin_amdgcn_sched_barrier(0);
        {
            bf16x8 kf[2][2][2];
#define CU_LOAD(buf, g_) do { _Pragma("unroll") for (int t4 = 0; t4 < 2; ++t4) _Pragma("unroll") for (int ks = 0; ks < 2; ++ks) \
                kf[buf][t4][ks] = *(const LAS bf16x8*)(Kt + (16 * (2 * (g_) + t4) + fr) * TP + 32 * ks + 8 * fq); } while (0)
            CU_LOAD(0, 0);
#pragma unroll
            for (int g = 0; g < 8; ++g) {
                if (g + 1 < 8) CU_LOAD((g + 1) & 1, g + 1);
#pragma unroll
                for (int t4 = 0; t4 < 2; ++t4) Cacc[2 * g + t4] = Cacc[2 * g + t4] * decay;
                __builtin_amdgcn_sched_barrier(0);
#pragma unroll
                for (int t4 = 0; t4 < 2; ++t4)
#pragma unroll
                    for (int ks = 0; ks < 2; ++ks) Cacc[2 * g + t4] = mfma16(kf[g & 1][t4][ks], vfr[ks], Cacc[2 * g + t4]);
                __builtin_amdgcn_sched_barrier(0);
            }
#undef CU_LOAD
        }
        __builtin_amdgcn_sched_barrier(0);
        {
            const int d = tid >> 1, half = tid & 1; float a = 0.f;
#pragma unroll
            for (int j = 0; j < 4; ++j) { const u32x4 kv = *(const LAS u32x4*)(Kt + d * TP + 32 * half + 8 * j);
                a += (bf_lo(kv.x) + bf_hi(kv.x)) + (bf_lo(kv.y) + bf_hi(kv.y)) + (bf_lo(kv.z) + bf_hi(kv.z)) + (bf_lo(kv.w) + bf_hi(kv.w)); }
            a += dpp_f<0xB1, 0xF>(a, a);
            if (half == 0) nS[(p ^ 1) * 256 + d] = decay * nS[p * 256 + d] + a;
        }
        m_prev = m_new; p ^= 1;
        __syncthreads();
    }
    { float* cp = C_out + (size_t)(4 * fq) * HD + eh * 128 + 16 * wid + fr;
#pragma unroll
      for (int t = 0; t < 16; ++t) {
#pragma unroll
        for (int i = 0; i < 4; ++i) cp[i * HD] = Cacc[t][i];
        cp += 16 * HD; asm volatile("" : "+v"(cp)); } }
    if (eh == 0) { if (tid < 256) n_out[tid] = nS[p * 256 + tid]; if (tid == 0) *m_out = m_prev; }
    __syncthreads();
}

__device__ __forceinline__ void phase_mlstm(const Frame& F) {
    const bf16_t* Qb = (const bf16_t*)(F.ws + WS_Q); const bf16_t* Kb = (const bf16_t*)(F.ws + WS_K); const bf16_t* Vb = (const bf16_t*)F.out;
    bf16_t* Hb = (bf16_t*)(F.ws + WS_U); const float* GATES = (const float*)(F.ws + WS_GATES);
    for (int it0 = F.bid; it0 < 768; it0 += F.G) {
        const bool prm = it0 < 256; const int it = prm ? it0 : it0 - 256;
        const int b = it >> 4, h = (it >> 1) & 7, eh = it & 1; const size_t bh = (size_t)b * 8 + h;
        mlstm_item(F.lds, Qb, Kb, Vb, Hb, GATES, prm ? b * SEQ : MP + b * DSEQ, prm ? SEQ / 64 : 1, prm ? 64 : DSEQ, h, eh,
                   prm ? nullptr : F.in[5] + bh * 65536, prm ? nullptr : F.in[6] + bh * 256, prm ? 0.f : F.in[7][bh],
                   F.out + (prm ? OUT_CP : OUT_CS) + bh * 65536, F.out + (prm ? OUT_NP : OUT_NS) + bh * 256, F.out + (prm ? OUT_MP : OUT_MS) + bh); }
}

__device__ __forceinline__ void phase_gn(const Frame& F) {
    bf16_t* Hb = (bf16_t*)(F.ws + WS_U); const bf16_t* Ob = (const bf16_t*)(F.ws + WS_O); const float* gnw = F.in[15]; const int lane = __lane_id();
    const int nw = F.G * 8;
    for (int rb = F.bid * 8 + F.wid; rb < M; rb += 2 * nw) {
        u32x4 hv[2][4], ov[2][4]; int rr[2]; bool ok[2];
#pragma unroll
        for (int q = 0; q < 2; ++q) { rr[q] = rb + q * nw; ok[q] = rr[q] < M; if (!ok[q]) rr[q] = rb;
#pragma unroll
            for (int j = 0; j < 4; ++j) { const size_t off = (size_t)rr[q] * D + j * 512 + lane * 8; hv[q][j] = *(const u32x4*)(Hb + off); ov[q][j] = *(const u32x4*)(Ob + off); } }
#pragma unroll
        for (int q = 0; q < 2; ++q)
#pragma unroll
        for (int j = 0; j < 4; ++j) { const int e = j * 512 + lane * 8; const size_t off = (size_t)rr[q] * D + e;
            const u32x4 h4 = hv[q][j], o4 = ov[q][j];
            float v[8];
            v[0] = bf_lo(h4.x) * sigmoidf_(bf_lo(o4.x)); v[1] = bf_hi(h4.x) * sigmoidf_(bf_hi(o4.x)); v[2] = bf_lo(h4.y) * sigmoidf_(bf_lo(o4.y)); v[3] = bf_hi(h4.y) * sigmoidf_(bf_hi(o4.y));
            v[4] = bf_lo(h4.z) * sigmoidf_(bf_lo(o4.z)); v[5] = bf_hi(h4.z) * sigmoidf_(bf_hi(o4.z)); v[6] = bf_lo(h4.w) * sigmoidf_(bf_lo(o4.w)); v[7] = bf_hi(h4.w) * sigmoidf_(bf_hi(o4.w));
            float s = ((v[0] + v[1]) + (v[2] + v[3])) + ((v[4] + v[5]) + (v[6] + v[7]));
#pragma unroll
            for (int o = 16; o >= 1; o >>= 1) s += __shfl_xor(s, o);
            const float mu = s * (1.0f / 256.0f); float qq = 0.f;
#pragma unroll
            for (int k = 0; k < 8; ++k) { v[k] -= mu; qq += v[k] * v[k]; }
#pragma unroll
            for (int o = 16; o >= 1; o >>= 1) qq += __shfl_xor(qq, o);
            const float rstd = rsqrtf(qq * (1.0f / 256.0f) + LN_EPS);
            const f32x4 g0 = *(const f32x4*)(gnw + e), g1 = *(const f32x4*)(gnw + e + 4);
            u32x4 w; w.x = cvt_pk_bf16(v[0] * rstd * g0[0], v[1] * rstd * g0[1]); w.y = cvt_pk_bf16(v[2] * rstd * g0[2], v[3] * rstd * g0[3]);
            w.z = cvt_pk_bf16(v[4] * rstd * g1[0], v[5] * rstd * g1[1]); w.w = cvt_pk_bf16(v[6] * rstd * g1[2], v[7] * rstd * g1[3]);
            if (ok[q]) *(u32x4*)(Hb + off) = w; }
    }
}

template <int MODE, int NSPLIT> __device__ __forceinline__ void phase_ln_rows(const Frame& F, const bf16_t* Xin, bf16_t* X1, const float* gam, const float* bet, const float* part, const float* gate, const bf16_t* x1b) {
    const float* MOD = (const float*)(F.ws + WS_MOD); bf16_t* U = (bf16_t*)(F.ws + WS_U); const int lane = __lane_id();
    const int nw = F.G * 8;
    for (int rb = F.bid * 8 + F.wid; rb < M; rb += 2 * nw) {
        float v[2][32]; int rr[2]; bool ok[2];
#pragma unroll
        for (int q = 0; q < 2; ++q) { rr[q] = rb + q * nw; ok[q] = rr[q] < M; if (!ok[q]) rr[q] = rb;
            if (rr[q] >= MP) {
                const int rs = rr[q] - MP; const float* gp = gate + (size_t)cond_of_row(rr[q]) * MODW;
#pragma unroll
                for (int j = 0; j < 4; ++j) { const int e = j * 512 + lane * 8; f32x4 t0 = (f32x4){0.f, 0.f, 0.f, 0.f}, t1 = t0;
#pragma unroll
                    for (int kb = 0; kb < NSPLIT; ++kb) { const float* pp = part + ((size_t)kb * MS + rs) * D + e; t0 += *(const f32x4*)pp; t1 += *(const f32x4*)(pp + 4); }
                    f32x4 s0, s1;
                    if (MODE == 0) { const float* sp = F.in[1] + (size_t)rs * D + e; s0 = *(const f32x4*)sp; s1 = *(const f32x4*)(sp + 4); }
                    else { const u32x4 w = *(const u32x4*)(x1b + (size_t)rr[q] * D + e); s0 = (f32x4){bf_lo(w.x), bf_hi(w.x), bf_lo(w.y), bf_hi(w.y)}; s1 = (f32x4){bf_lo(w.z), bf_hi(w.z), bf_lo(w.w), bf_hi(w.w)}; }
                    const f32x4 g0 = *(const f32x4*)(gp + e), g1 = *(const f32x4*)(gp + e + 4);
                    s0 = s0 * ALPHA + g0 * t0; s1 = s1 * ALPHA + g1 * t1;
#pragma unroll
                    for (int k = 0; k < 4; ++k) { v[q][8 * j + k] = s0[k]; v[q][8 * j + 4 + k] = s1[k]; } }
            } else
#pragma unroll
            for (int j = 0; j < 4; ++j) { const u32x4 w = *(const u32x4*)(Xin + (size_t)rr[q] * D + j * 512 + lane * 8);
                v[q][8 * j + 0] = bf_lo(w.x); v[q][8 * j + 1] = bf_hi(w.x); v[q][8 * j + 2] = bf_lo(w.y); v[q][8 * j + 3] = bf_hi(w.y);
                v[q][8 * j + 4] = bf_lo(w.z); v[q][8 * j + 5] = bf_hi(w.z); v[q][8 * j + 6] = bf_lo(w.w); v[q][8 * j + 7] = bf_hi(w.w); } }
#pragma unroll
        for (int q = 0; q < 2; ++q) {
            float s = 0.f;
#pragma unroll
            for (int k = 0; k < 32; ++k) s += v[q][k];
            const float mu = wave_sum(s) * (1.0f / D); float qq = 0.f;
#pragma unroll
            for (int k = 0; k < 32; ++k) { v[q][k] -= mu; qq += v[q][k] * v[q][k]; }
            const float rstd = rsqrtf(wave_sum(qq) * (1.0f / D) + LN_EPS); float s2 = 0.f;
#pragma unroll
            for (int j = 0; j < 4; ++j) { const int e = j * 512 + lane * 8;
                const f32x4 g0 = *(const f32x4*)(gam + e), g1 = *(const f32x4*)(gam + e + 4), b0 = *(const f32x4*)(bet + e), b1 = *(const f32x4*)(bet + e + 4);
#pragma unroll
                for (int k = 0; k < 4; ++k) { v[q][8 * j + k] = v[q][8 * j + k] * rstd * g0[k] + b0[k]; v[q][8 * j + 4 + k] = v[q][8 * j + 4 + k] * rstd * g1[k] + b1[k]; }
#pragma unroll
                for (int k = 0; k < 8; ++k) s2 += v[q][8 * j + k];
                if (ok[q]) {
                    if (MODE == 0) { u32x4 w; w.x = cvt_pk_bf16(v[q][8 * j], v[q][8 * j + 1]); w.y = cvt_pk_bf16(v[q][8 * j + 2], v[q][8 * j + 3]); w.z = cvt_pk_bf16(v[q][8 * j + 4], v[q][8 * j + 5]); w.w = cvt_pk_bf16(v[q][8 * j + 6], v[q][8 * j + 7]);
                        *(u32x4*)(X1 + (size_t)rr[q] * D + e) = w; }
                    else { float* op = F.out + (size_t)rr[q] * D + e; *(f32x4*)op = (f32x4){v[q][8 * j], v[q][8 * j + 1], v[q][8 * j + 2], v[q][8 * j + 3]}; *(f32x4*)(op + 4) = (f32x4){v[q][8 * j + 4], v[q][8 * j + 5], v[q][8 * j + 6], v[q][8 * j + 7]}; } } }
            if (MODE == 0) {
                const float mu2 = wave_sum(s2) * (1.0f / D); float q2 = 0.f;
#pragma unroll
                for (int k = 0; k < 32; ++k) { v[q][k] -= mu2; q2 += v[q][k] * v[q][k]; }
                const float rstd2 = rsqrtf(wave_sum(q2) * (1.0f / D) + LN_EPS);
                const float* sh = MOD + (size_t)cond_of_row(rr[q]) * MODW + 3 * D; const float* sc = sh + D;
#pragma unroll
                for (int j = 0; j < 4; ++j) { const int e = j * 512 + lane * 8;
                    const f32x4 c0 = *(const f32x4*)(sc + e), c1 = *(const f32x4*)(sc + e + 4), h0 = *(const f32x4*)(sh + e), h1 = *(const f32x4*)(sh + e + 4);
                    float o[8];
#pragma unroll
                    for (int k = 0; k < 4; ++k) { o[k] = v[q][8 * j + k] * rstd2 * (c0[k] + 1.0f) + h0[k]; o[4 + k] = v[q][8 * j + 4 + k] * rstd2 * (c1[k] + 1.0f) + h1[k]; }
                    u32x4 w; w.x = cvt_pk_bf16(o[0], o[1]); w.y = cvt_pk_bf16(o[2], o[3]); w.z = cvt_pk_bf16(o[4], o[5]); w.w = cvt_pk_bf16(o[6], o[7]);
                    if (ok[q]) *(u32x4*)(U + (size_t)rr[q] * D + e) = w; }
            }
        }
    }
}

__global__ void __launch_bounds__(NTHREADS, 2) fwd_kernel(KArgs a) {
    extern __shared__ __attribute__((aligned(16))) unsigned char lds_raw[];
    Frame F;
    F.lds = (LAS unsigned char*)lds_raw;
    F.in = a.in;
    F.out = a.out; F.ws = a.ws;
    F.tid = threadIdx.x; F.lane = F.tid & 63; F.wid = __builtin_amdgcn_readfirstlane(F.tid >> 6); F.G = gridDim.x; F.bid = blockIdx.x;
    const int lo = a.ph_lo, hi = a.ph_hi;
    unsigned char* ws = a.ws; unsigned char* ob = (unsigned char*)a.out;
    bf16_t* U = (bf16_t*)(ws + WS_U); bf16_t* Qb = (bf16_t*)(ws + WS_Q); bf16_t* Kb = (bf16_t*)(ws + WS_K); bf16_t* Ob = (bf16_t*)(ws + WS_O);
    bf16_t* GA = (bf16_t*)(ws + WS_GA); bf16_t* GB = (bf16_t*)(ws + WS_GB);
    bf16_t* Vb = (bf16_t*)ob; bf16_t* Pb = (bf16_t*)(ob + SZ_TOK); bf16_t* Yb = (bf16_t*)(ob + SZ_TOK + (size_t)M * PW * 2);
    bf16_t* TMP = Qb; bf16_t* MRG = Kb; bf16_t* HM = Qb; bf16_t* AOUT = Pb;
    float* PART = (float*)(ws + WS_PART);
    bf16_t* XA = GA; bf16_t* XB = GB;
    const float* MOD = (const float*)(ws + WS_MOD);
#ifndef ONLY_PHASE
#define ONLY_PHASE -1
#endif
#define IN(k) ((ONLY_PHASE < 0 || ONLY_PHASE == (k)) && lo <= (k) && (k) < hi)
#define SEAM(k) do { if (IN(k) && IN((k) + 1)) { if ((k) == 0) cg::this_grid().sync(); else xcd_barrier(xbar); } } while (0)
    volatile LAS unsigned* xst = (volatile LAS unsigned*)(F.lds + LDS_BYTES - 16);
    if (F.tid < 4) xst[F.tid] = 0u;
    __syncthreads();
    XcdBarrier xbar; xbar.bar = (unsigned*)ws; xbar.x = 0; xbar.st = xst;
    if (hi - lo > 1) xbar = xcd_barrier_post((unsigned*)ws, xst);

    if (IN(0)) REP(0) phase_prologue(F);
    SEAM(0);
    if (IN(1)) REP(1) phase_ln_in(F);
    SEAM(1);
    if (IN(2)) REP(2) { pg8::Gemm g{U, (const bf16_t*)(ws + WS_WIN), D, D, D, 0, D}; pg8::StaticOrder S; S.init(M / 256, NMAIN / 256, F.G, F.bid);
        EpiProj E{Pb, Qb, Kb, Vb, Ob, GA, GB}; pg8::gemm_phase<EpiProj, pg8::StaticOrder, pg8::NoSub, true>(F.lds, g, S, E); }
    SEAM(2);
    if (IN(3)) REP(3) { REP(30) phase_pool(F); REP(31) phase_mlstm(F); }
    SEAM(3);
    if (IN(4)) { pg8::Gemm g{Yb, (const bf16_t*)(ws + WS_WPOOL), PW, 256, 256, 512, 256}; pg8::StaticOrder S; S.init(M / 256, 4, F.G, F.bid);
        EpiPool E{AOUT, F.in[14]}; pg8::gemm_phase<EpiPool>(F.lds, g, S, E);
        phase_gn(F); }
    SEAM(4);
    if (IN(5)) REP(5) { pg8::Gemm g{AOUT, (const bf16_t*)(ws + WS_WPA), PW, PW, PW, 0, PW / 4}; pg8::SplitOrder S; S.init(MP / 256, D / 256, MS / 256, 4, F.G, F.bid);
        EpiMerge<0> E{GA, nullptr, TMP}; EpiPartial EP{PART}; pg8::gemm_phase<EpiMerge<0>, pg8::SplitOrder, EpiPartial, true>(F.lds, g, S, E, EP); }
    if (IN(6)) REP(6) { pg8::Gemm g{U, (const bf16_t*)(ws + WS_WPB), D, D, D, 0, D / 4}; pg8::SplitOrder S; S.init(MP / 256, D / 256, MS / 256, 4, F.G, F.bid);
        EpiMerge<1> E{GB, TMP, MRG}; EpiPartial EP{PART + (size_t)4 * MS * D}; pg8::gemm_phase<EpiMerge<1>, pg8::SplitOrder, EpiPartial, true>(F.lds, g, S, E, EP); }
    SEAM(6);
    if (IN(7)) {
        for (int idx = F.bid * NTHREADS + F.tid; idx < MS * (D / 8); idx += F.G * NTHREADS) { const int rs = idx >> 8, c = (idx & 255) * 8; const size_t off = (size_t)(MP + rs) * D + c;
            const u32x4 ga4 = *(const u32x4*)(GA + off), gb4 = *(const u32x4*)(GB + off);
            f32x4 a0 = (f32x4){0.f, 0.f, 0.f, 0.f}, a1 = a0, b0 = a0, b1 = a0;
#pragma unroll
            for (int kb = 0; kb < 4; ++kb) { const float* pa = PART + ((size_t)kb * MS + rs) * D + c; const float* pb = pa + (size_t)4 * MS * D;
                a0 += *(const f32x4*)pa; a1 += *(const f32x4*)(pa + 4); b0 += *(const f32x4*)pb; b1 += *(const f32x4*)(pb + 4); }
            float o[8];
            o[0] = sigmoidf_(bf_lo(ga4.x)) * a0[0] + sigmoidf_(bf_lo(gb4.x)) * b0[0]; o[1] = sigmoidf_(bf_hi(ga4.x)) * a0[1] + sigmoidf_(bf_hi(gb4.x)) * b0[1];
            o[2] = sigmoidf_(bf_lo(ga4.y)) * a0[2] + sigmoidf_(bf_lo(gb4.y)) * b0[2]; o[3] = sigmoidf_(bf_hi(ga4.y)) * a0[3] + sigmoidf_(bf_hi(gb4.y)) * b0[3];
            o[4] = sigmoidf_(bf_lo(ga4.z)) * a1[0] + sigmoidf_(bf_lo(gb4.z)) * b1[0]; o[5] = sigmoidf_(bf_hi(ga4.z)) * a1[1] + sigmoidf_(bf_hi(gb4.z)) * b1[1];
            o[6] = sigmoidf_(bf_lo(ga4.w)) * a1[2] + sigmoidf_(bf_lo(gb4.w)) * b1[2]; o[7] = sigmoidf_(bf_hi(ga4.w)) * a1[3] + sigmoidf_(bf_hi(gb4.w)) * b1[3];
            u32x4 w; w.x = cvt_pk_bf16(o[0], o[1]); w.y = cvt_pk_bf16(o[2], o[3]); w.z = cvt_pk_bf16(o[4], o[5]); w.w = cvt_pk_bf16(o[6], o[7]);
            *(u32x4*)(MRG + off) = w; }
        if (hi - lo > 1) xcd_barrier(xbar);
    }
    if (IN(7)) REP(7) { pg8::Gemm g{MRG, (const bf16_t*)(ws + WS_WOUT), D, D, D, 0, D / 8}; pg8::SplitOrder S; S.init(MP / 256, D / 256, MS / 256, 8, F.G, F.bid);
        EpiRes<0> E{F.in[0], F.in[1], nullptr, MOD + 2 * D, XA}; EpiPartial EP{PART}; pg8::gemm_phase<EpiRes<0>, pg8::SplitOrder, EpiPartial, true>(F.lds, g, S, E, EP); }
    SEAM(7);
    if (IN(8)) phase_ln_rows<0, 8>(F, XA, XB, F.in[19], F.in[20], PART, MOD + 2 * D, nullptr);
    SEAM(8);
    if (IN(9)) REP(9) { pg8::Gemm g{U, (const bf16_t*)(ws + WS_WGU), D, D, D, 0, D}; pg8::StaticOrder S; S.init(M / 256, 2 * DFF / 256, F.G, F.bid);
        EpiSwiglu E{HM}; pg8::gemm_phase<EpiSwiglu, pg8::StaticOrder, pg8::NoSub, true>(F.lds, g, S, E); }
    SEAM(9);
    if (IN(10)) { pg8::Gemm g{HM, (const bf16_t*)(ws + WS_WDOWN), DFF, DFF, DFF, 0, DFF / 4}; pg8::SplitOrder S; S.init(MP / 256, D / 256, MS / 256, 4, F.G, F.bid);
        EpiRes<1> E{nullptr, nullptr, XB, MOD + 5 * D, XA}; EpiPartial EP{PART}; pg8::gemm_phase<EpiRes<1>, pg8::SplitOrder, EpiPartial, true>(F.lds, g, S, E, EP); }
    SEAM(10);
    if (IN(11)) phase_ln_rows<1, 4>(F, XA, nullptr, F.in[24], F.in[25], PART, MOD + 5 * D, XB);
#undef IN
#undef SEAM
}

extern "C" void kernel_launch(void* const* d_in, const int* in_sizes, int n_in, void* d_out, int out_size, void* d_ws, size_t ws_size, hipStream_t stream) {
    static int grid = 0;
    if (grid == 0) {
        if (n_in != 26 || in_sizes[0] != MP * D || (size_t)out_size != OUT_END || ws_size < WS_END) {
            fprintf(stderr, "kernel_launch: unexpected shapes (n_in %d, in0 %d, out %d, ws %zu; need ws >= %zu)\n", n_in, n_in > 0 ? in_sizes[0] : -1, out_size, ws_size, (size_t)WS_END); grid = -1; return; }
        int dev = 0, cus = 0, per_cu = 0;
        if (hipGetDevice(&dev) != hipSuccess || hipDeviceGetAttribute(&cus, hipDeviceAttributeMultiprocessorCount, dev) != hipSuccess) { grid = -1; return; }
        if (hipFuncSetAttribute((const void*)fwd_kernel, hipFuncAttributeMaxDynamicSharedMemorySize, LDS_BYTES) != hipSuccess) { fprintf(stderr, "kernel_launch: hipFuncSetAttribute failed\n"); grid = -1; return; }
        if (hipOccupancyMaxActiveBlocksPerMultiprocessor(&per_cu, (const void*)fwd_kernel, NTHREADS, LDS_BYTES) != hipSuccess || per_cu < 1) { fprintf(stderr, "kernel_launch: occupancy query says %d\n", per_cu); per_cu = 1; }
        (void)hipGetLastError();
        grid = cus * 1;
    }
    if (grid < 0) return;
    if (hipMemsetAsync(d_ws, 0, 16384, stream) != hipSuccess) { fprintf(stderr, "kernel_launch: hipMemsetAsync failed\n"); return; }
    KArgs a{};
    for (int i = 0; i < 26; ++i) a.in[i] = (const float*)d_in[i];
    a.out = (float*)d_out; a.ws = (unsigned char*)d_ws;
#if ONE_LAUNCH
    a.ph_lo = 0; a.ph_hi = NPHASES;
    void* args[] = {&a};
    hipError_t e = hipLaunchCooperativeKernel((const void*)fwd_kernel, dim3(grid), dim3(NTHREADS), args, LDS_BYTES, stream);
    if (e != hipSuccess) fprintf(stderr, "kernel_launch: cooperative launch failed: %s (grid %d)\n", hipGetErrorString(e), grid);
#else
    for (int ph = 0; ph < NPHASES; ++ph) { a.ph_lo = ph; a.ph_hi = ph + 1;
        hipLaunchKernelGGL(fwd_kernel, dim3(grid), dim3(NTHREADS), LDS_BYTES, stream, a); }
#endif
}
```

```cpp
#include <hip/hip_runtime.h>
#include <hip/hip_cooperative_groups.h>
#include <cstdio>
namespace cg = cooperative_groups;

#ifndef PG8_SP2
#define PG8_SP2 true
#endif
#ifndef PG8_ALIGN
#define PG8_ALIGN true
#endif
#ifndef ONE_LAUNCH
#define ONE_LAUNCH 1
#endif

#ifndef REPEAT_PHASE
#define REPEAT_PHASE -1
#endif
#define REP(k) for (int rep_##k = 0; rep_##k < ((REPEAT_PHASE == (k)) ? 2 : 1); ++rep_##k)
#define LAS __attribute__((address_space(3)))
typedef unsigned short bf16_t;
typedef short bf16x8 __attribute__((ext_vector_type(8)));
typedef float f32x4 __attribute__((ext_vector_type(4)));
typedef unsigned u32x4 __attribute__((ext_vector_type(4)));
typedef unsigned u32x2 __attribute__((ext_vector_type(2)));

constexpr int D = 2048, MP = 16 * 2048, MS = 32 * 32, M = MP + MS;
constexpr int SEQ = 2048, DSEQ = 32, PW = 1024, HD = 256, DFF = 5632, NIN = 13328, NMAIN = 13312;
constexpr int MODW = 6 * D;
constexpr float ALPHA = 1.18920711500272f, LN_EPS = 1e-5f;
constexpr int NTHREADS = 512, LDS_BYTES = 144 * 1024;
constexpr int NPHASES = 12;

constexpr size_t SZ_TOK = (size_t)M * D * 2;
constexpr size_t WS_MOD = 16384;
constexpr size_t WS_GATES = WS_MOD + (size_t)48 * MODW * 4;
constexpr size_t WS_WIN = WS_GATES + (size_t)M * 16 * 4;
constexpr size_t WS_WPOOL = WS_WIN + (size_t)NMAIN * D * 2;
constexpr size_t WS_WPA = WS_WPOOL + (size_t)4 * 256 * 256 * 2;
constexpr size_t WS_WPB = WS_WPA + (size_t)D * PW * 2;
constexpr size_t WS_WOUT = WS_WPB + (size_t)D * D * 2;
constexpr size_t WS_WGU = WS_WOUT + (size_t)D * D * 2;
constexpr size_t WS_WDOWN = WS_WGU + (size_t)2 * DFF * D * 2;
constexpr size_t WS_U = WS_WDOWN + (size_t)D * DFF * 2;
constexpr size_t WS_Q = WS_U + SZ_TOK;
constexpr size_t WS_K = WS_Q + SZ_TOK;
constexpr size_t WS_O = WS_K + SZ_TOK;
constexpr size_t WS_GA = WS_O + SZ_TOK;
constexpr size_t WS_GB = WS_GA + SZ_TOK;
constexpr size_t WS_PART = WS_GB + SZ_TOK;
constexpr size_t WS_END = WS_PART + (size_t)8 * MS * D * 4;
constexpr size_t OUT_POOLP = (size_t)M * D;
constexpr size_t OUT_CP = OUT_POOLP + (size_t)16 * 15 * PW;
constexpr size_t OUT_NP = OUT_CP + (size_t)16 * 8 * 256 * 256;
constexpr size_t OUT_MP = OUT_NP + (size_t)16 * 8 * 256;
constexpr size_t OUT_POOLS = OUT_MP + 16 * 8;
constexpr size_t OUT_CS = OUT_POOLS + (size_t)32 * 15 * PW;
constexpr size_t OUT_NS = OUT_CS + (size_t)32 * 8 * 256 * 256;
constexpr size_t OUT_MS = OUT_NS + (size_t)32 * 8 * 256;
constexpr size_t OUT_END = OUT_MS + 32 * 8;

__device__ __forceinline__ unsigned cvt_pk_bf16(float lo, float hi) { unsigned r; asm volatile("v_cvt_pk_bf16_f32 %0, %1, %2" : "=v"(r) : "v"(lo), "v"(hi)); return r; }
__device__ __forceinline__ float bf_lo(unsigned w) { return __uint_as_float(w << 16); }
__device__ __forceinline__ float bf_hi(unsigned w) { return __uint_as_float(w & 0xffff0000u); }
__device__ __forceinline__ float sigmoidf_(float x) { return 1.0f / (1.0f + __expf(-x)); }
__device__ __forceinline__ int cond_of_row(int r) { return r < MP ? (r >> 11) : 16 + ((r - MP) >> 5); }
__device__ __forceinline__ float wave_sum(float v) {
#pragma unroll
    for (int o = 32; o >= 1; o >>= 1) v += __shfl_xor(v, o);
    return v;
}
__device__ __forceinline__ f32x4 mfma16(bf16x8 a, bf16x8 b, f32x4 c) { return __builtin_amdgcn_mfma_f32_16x16x32_bf16(a, b, c, 0, 0, 0); }
__device__ __forceinline__ bf16x8 as_bf16x8(u32x4 v) { return __builtin_bit_cast(bf16x8, v); }

namespace pg8 {
constexpr int BM = 256, BK = 64, HALF = 128, HTB = HALF * BK * 2, STAGE_BYTES = 8 * HTB, NXCD = 8, WGM = 4;
__host__ __device__ __forceinline__ int lds_byte(int r, int c) { const int st = (r >> 4) * 2 + (c >> 5), rr = r & 15, cc = c & 31, ob = rr * 64 + cc * 2; return st * 1024 + (ob ^ (((ob >> 9) & 1) << 5)); }
__host__ __device__ __forceinline__ void stage_rc(int b, int& R, int& C) { const int st = b / 1024, sb = b % 1024, swz = sb ^ (((sb >> 9) & 1) << 5); R = (st >> 1) * 16 + swz / 64; C = (st & 1) * 32 + (swz % 64) / 2; }
__host__ __device__ __forceinline__ int perm32(int rho) { const int n = rho >> 4, i = rho & 15; return 8 * (i >> 2) + 4 * n + (i & 3); }

struct Unit { int pm, pn, kb; };
struct Gemm { const bf16_t* A; const bf16_t* Bt; int lda, ldb, K, acs, Ksub; };

struct StaticOrder {
    int nM, nN, nwg, G, c;
    __device__ void init(int nM_, int nN_, int G_, int c_) { nM = nM_; nN = nN_; nwg = nM * nN; G = G_; c = c_; }
    __device__ bool next(int i, Unit& u) const {
        const long L = (long)i * G + c; if (L >= nwg) return false;
        int wgid = (int)L; { const int q = nwg / NXCD, r = nwg % NXCD, xcd = wgid % NXCD, off = wgid / NXCD; wgid = (xcd < r ? xcd * (q + 1) : r * (q + 1) + (xcd - r) * q) + off; }
        const int nig = WGM * nN, gid = wgid / nig, fm = gid * WGM, gsz = (nM - fm) < WGM ? (nM - fm) : WGM;
        u.pm = fm + ((wgid % nig) % gsz); u.pn = (wgid % nig) / gsz; u.kb = -1; return true;
    }
};
struct SplitOrder {
    StaticOrder main; int nMs, ns, nsub;
    __device__ void init(int nM_, int nN_, int nMs_, int ns_, int G_, int c_) { main.init(nM_, nN_, G_, c_); nMs = nMs_; ns = ns_; nsub = nMs_ * nN_ * ns_; }
    __device__ bool next(int i, Unit& u) const {
        const long L = (long)i * main.G + main.c;
        if (L < main.nwg) return main.next(i, u);
        const int j = (int)(L - main.nwg); if (j >= nsub) return false;
        u.pn = j % main.nN; u.pm = main.nM + (j / main.nN) % nMs; u.kb = j / (main.nN * nMs); return true;
    }
};
struct NoSub { template <class A> __device__ __forceinline__ void operator()(const A&, const Unit&, int, int, int, int) const {} };

template <class Epi, class Sched = StaticOrder, class EpiSub = NoSub, bool FAST = false>
__device__ __forceinline__ void gemm_phase(LAS unsigned char* lds, const Gemm g, const Sched& S, const Epi& E, const EpiSub& ES = EpiSub()) {
    const int tid = threadIdx.x, wid = __builtin_amdgcn_readfirstlane(tid >> 6), lane = tid & 63, wr = wid >> 2, wc = wid & 3, fr = lane & 15, fq = lane >> 4;
    const int ntMain = g.K / BK, ntSub = g.Ksub / BK; const size_t ksubB = (size_t)g.Ksub * 2;
    unsigned voffA[2], voffB[2];
#pragma unroll
    for (int i = 0; i < 2; ++i) { int R, C; stage_rc(tid * 16 + i * 8192, R, C); const int Rb = Epi::PERM ? ((R & ~31) + perm32(R & 31)) : R;
        voffA[i] = (unsigned)(R * g.lda + C) * 2u; voffB[i] = (unsigned)(Rb * g.ldb + C) * 2u; }
    const size_t kstep = (size_t)(BK * 2);
    const size_t hstepA = (size_t)HALF * g.lda * 2, hstepB = (size_t)HALF * g.ldb * 2;
    const size_t tstepA = 2 * hstepA, tstepB = 2 * hstepB;
    const unsigned ldsw = (unsigned)wid * 1024u;
    const int aoff = lds_byte(wr * 64 + fr, fq * 8), boff = lds_byte(wc * 32 + fr, fq * 8);
#define PG8_SA(b, h) (((b) * 2 + (h)) * HTB)
#define PG8_SB(b, h) ((4 + (b) * 2 + (h)) * HTB)
#define PG8_STAGE(bufoff, gbase, voff) do { _Pragma("unroll") for (int _i = 0; _i < 2; ++_i) \
        __builtin_amdgcn_global_load_lds((const unsigned*)((const char*)(gbase) + (voff)[_i]), (LAS unsigned*)(lds + (bufoff) + ldsw + _i * 8192), 16, 0, 0); } while (0)
#define PG8_LDA(dst, b, h) do { _Pragma("unroll") for (int m = 0; m < 4; ++m) _Pragma("unroll") for (int k = 0; k < 2; ++k) dst[m][k] = *(const LAS bf16x8*)(lds + PG8_SA(b, h) + aoff + m * 2048 + k * 1024); } while (0)
#define PG8_LDB(dst, b, h) do { _Pragma("unroll") for (int n = 0; n < 2; ++n) _Pragma("unroll") for (int k = 0; k < 2; ++k) dst[n][k] = *(const LAS bf16x8*)(lds + PG8_SB(b, h) + boff + n * 2048 + k * 1024); } while (0)
#define PG8_MMA(ai, bj, At, Bt) do { __builtin_amdgcn_s_setprio(1); _Pragma("unroll") for (int m = 0; m < 4; ++m) _Pragma("unroll") for (int n = 0; n < 2; ++n) _Pragma("unroll") for (int k = 0; k < 2; ++k) \
        acc[ai][bj][m][n] = __builtin_amdgcn_mfma_f32_16x16x32_bf16(Bt[n][k], At[m][k], acc[ai][bj][m][n], 0, 0, 0); __builtin_amdgcn_s_setprio(0); } while (0)
#define PG8_WAIT_V(n) asm volatile("s_waitcnt vmcnt(" #n ")" ::: "memory")
#define PG8_WAIT_L(n) asm volatile("s_waitcnt lgkmcnt(" #n ")" ::: "memory")
#define PG8_BAR __builtin_amdgcn_s_barrier()
#define PG8_SCHED __builtin_amdgcn_sched_barrier(0)
    Unit cur, nxt; int ui = 0;
    if (!S.next(0, cur)) return;
    f32x4 acc[2][2][4][2];
#pragma unroll
    for (int a = 0; a < 2; ++a)
#pragma unroll
        for (int b = 0; b < 2; ++b)
#pragma unroll
            for (int m = 0; m < 4; ++m)
#pragma unroll
                for (int n = 0; n < 2; ++n) acc[a][b][m][n] = (f32x4){0.f, 0.f, 0.f, 0.f};
    bf16x8 At[4][2], B0[2][2], B1[2][2];
    const char* cA = (const char*)g.A + (size_t)cur.pm * tstepA + (size_t)cur.pn * g.acs + (cur.kb < 0 ? 0 : cur.kb * ksubB); const char* cB = (const char*)g.Bt + (size_t)cur.pn * tstepB + (cur.kb < 0 ? 0 : cur.kb * ksubB);
    if constexpr (FAST && PG8_SP2) {
        PG8_STAGE(PG8_SB(0, 0), cB, voffB); PG8_STAGE(PG8_SB(0, 1), cB + hstepB, voffB); PG8_STAGE(PG8_SA(0, 0), cA, voffA); PG8_STAGE(PG8_SA(0, 1), cA + hstepA, voffA);
        if (wr == 1) PG8_BAR;
        PG8_WAIT_V(2); PG8_BAR;
        PG8_STAGE(PG8_SB(1, 0), cB + kstep, voffB); PG8_STAGE(PG8_SA(1, 0), cA + kstep, voffA); PG8_STAGE(PG8_SB(1, 1), cB + hstepB + kstep, voffB);
        PG8_WAIT_V(6); PG8_BAR;
    } else {
    PG8_STAGE(PG8_SB(0, 0), cB, voffB); PG8_STAGE(PG8_SA(0, 0), cA, voffA); PG8_STAGE(PG8_SB(0, 1), cB + hstepB, voffB); PG8_STAGE(PG8_SA(0, 1), cA + hstepA, voffA);
    if (wr == 1) PG8_BAR;
    PG8_WAIT_V(4); PG8_BAR;
    PG8_STAGE(PG8_SB(1, 0), cB + kstep, voffB); PG8_STAGE(PG8_SA(1, 0), cA + kstep, voffA); PG8_STAGE(PG8_SB(1, 1), cB + hstepB + kstep, voffB);
    PG8_WAIT_V(6); PG8_BAR;
    }
    for (;;) {
        const bool has_next = S.next(ui + 1, nxt);
        const size_t nko = (has_next && nxt.kb >= 0) ? nxt.kb * ksubB : 0;
        const char* nA = has_next ? (const char*)g.A + (size_t)nxt.pm * tstepA + (size_t)nxt.pn * g.acs + nko : cA; const char* nB = has_next ? (const char*)g.Bt + (size_t)nxt.pn * tstepB + nko : cB;
        const int nt = cur.kb < 0 ? ntMain : ntSub;
        for (int t = 0; t < nt; t += 2) {
            const bool last = (t == nt - 2);
            const char* a1 = cA + (size_t)(t + 1) * kstep;
            const char* a2 = last ? nA : cA + (size_t)(t + 2) * kstep; const char* b2 = last ? nB : cB + (size_t)(t + 2) * kstep;
            const char* a3 = a2 + kstep; const char* b3 = b2 + kstep;
            if constexpr (FAST && PG8_SP2) {
            PG8_LDB(B0, 0, 0); PG8_LDB(B1, 0, 1); PG8_SCHED; PG8_LDA(At, 0, 0); PG8_STAGE(PG8_SA(1, 1), a1 + hstepA, voffA);
            PG8_WAIT_V(8); PG8_WAIT_L(0); PG8_BAR; PG8_MMA(0, 0, At, B0); PG8_MMA(0, 1, At, B1); PG8_BAR; PG8_SCHED;
            PG8_LDA(At, 0, 1); PG8_STAGE(PG8_SB(0, 0), b2, voffB); PG8_STAGE(PG8_SB(0, 1), b2 + hstepB, voffB); PG8_STAGE(PG8_SA(0, 0), a2, voffA);
            PG8_WAIT_V(8); PG8_WAIT_L(0); PG8_BAR; PG8_MMA(1, 0, At, B0); PG8_MMA(1, 1, At, B1); PG8_BAR; PG8_SCHED;
            PG8_LDB(B0, 1, 0); PG8_LDB(B1, 1, 1); PG8_SCHED; PG8_LDA(At, 1, 0); PG8_STAGE(PG8_SA(0, 1), a2 + hstepA, voffA);
            PG8_WAIT_V(8); PG8_WAIT_L(0); PG8_BAR; PG8_MMA(0, 0, At, B0); PG8_MMA(0, 1, At, B1); PG8_BAR; PG8_SCHED;
            PG8_LDA(At, 1, 1); PG8_STAGE(PG8_SB(1, 0), b3, voffB); PG8_STAGE(PG8_SB(1, 1), b3 + hstepB, voffB); PG8_STAGE(PG8_SA(1, 0), a3, voffA);
            PG8_WAIT_V(8); PG8_WAIT_L(0); PG8_BAR; PG8_MMA(1, 0, At, B0); PG8_MMA(1, 1, At, B1); PG8_BAR; PG8_SCHED;
            } else {
            PG8_LDB(B0, 0, 0); PG8_SCHED; PG8_LDA(At, 0, 0); PG8_STAGE(PG8_SA(1, 1), a1 + hstepA, voffA);
            PG8_WAIT_L(8); PG8_BAR; PG8_WAIT_L(0); PG8_MMA(0, 0, At, B0); PG8_BAR; PG8_SCHED;
            PG8_LDB(B1, 0, 1); PG8_STAGE(PG8_SB(0, 0), b2, voffB);
            PG8_BAR; PG8_WAIT_L(0); PG8_MMA(0, 1, At, B1); PG8_BAR;
            PG8_LDA(At, 0, 1); PG8_STAGE(PG8_SA(0, 0), a2, voffA);
            PG8_BAR; PG8_WAIT_L(0); PG8_MMA(1, 0, At, B0); PG8_BAR; PG8_SCHED;
            PG8_STAGE(PG8_SB(0, 1), b2 + hstepB, voffB);
            PG8_WAIT_V(6); PG8_BAR; PG8_MMA(1, 1, At, B1); PG8_BAR;
            PG8_LDB(B0, 1, 0); PG8_SCHED; PG8_LDA(At, 1, 0); PG8_STAGE(PG8_SA(0, 1), a2 + hstepA, voffA);
            PG8_WAIT_L(8); PG8_BAR; PG8_WAIT_L(0); PG8_MMA(0, 0, At, B0); PG8_BAR; PG8_SCHED;
            PG8_LDB(B1, 1, 1); PG8_STAGE(PG8_SB(1, 0), b3, voffB);
            PG8_BAR; PG8_WAIT_L(0); PG8_MMA(0, 1, At, B1); PG8_BAR;
            PG8_LDA(At, 1, 1); PG8_STAGE(PG8_SA(1, 0), a3, voffA);
            PG8_BAR; PG8_WAIT_L(0); PG8_MMA(1, 0, At, B0); PG8_BAR; PG8_SCHED;
            PG8_STAGE(PG8_SB(1, 1), b3 + hstepB, voffB);
            PG8_WAIT_V(6); PG8_BAR; PG8_MMA(1, 1, At, B1); PG8_BAR;
            }
        }
        if constexpr (FAST && PG8_ALIGN) { if (wr == 0) PG8_BAR; }
        if (cur.kb < 0) E(acc, cur, wr, wc, fr, fq); else ES(acc, cur, wr, wc, fr, fq);
        if (Epi::DOUBLE) { asm volatile("" ::: "memory"); if (cur.kb < 0) E(acc, cur, wr, wc, fr, fq); else ES(acc, cur, wr, wc, fr, fq); }
        if (!has_next) break;
#pragma unroll
        for (int a = 0; a < 2; ++a)
#pragma unroll
            for (int b = 0; b < 2; ++b)
#pragma unroll
                for (int m = 0; m < 4; ++m)
#pragma unroll
                    for (int n = 0; n < 2; ++n) acc[a][b][m][n] = (f32x4){0.f, 0.f, 0.f, 0.f};
        cur = nxt; cA = nA; cB = nB; ++ui;
        if constexpr (FAST && PG8_ALIGN) { if (wr == 1) PG8_BAR; }
    }
    PG8_WAIT_V(0);
    if constexpr (!(FAST && PG8_ALIGN)) { if (wr == 0) PG8_BAR; }
    PG8_BAR;
#undef PG8_SA
#undef PG8_SB
#undef PG8_STAGE
#undef PG8_LDA
#undef PG8_LDB
#undef PG8_MMA
#undef PG8_WAIT_V
#undef PG8_WAIT_L
#undef PG8_BAR
#undef PG8_SCHED
}
}
using pg8::Unit;

typedef f32x4 AccT[2][2][4][2];

struct EpiProj {
    static constexpr bool PERM = true, DOUBLE = (REPEAT_PHASE == 50);
    bf16_t *P, *Q, *Kb, *V, *O, *GA, *GB;
    __device__ __forceinline__ void operator()(const AccT& acc, const Unit& u, int wr, int wc, int fr, int fq) const {
        bf16_t* base; int ldc, colt;
        if (u.pn < 4) { base = P; ldc = PW; colt = u.pn * 256; }
        else { const int t = (u.pn - 4) >> 3; colt = ((u.pn - 4) & 7) * 256; ldc = D;
            base = t == 0 ? Q : t == 1 ? Kb : t == 2 ? V : t == 3 ? O : t == 4 ? GA : GB; }
        const int row0 = u.pm * 256 + wr * 64 + fr, col0 = colt + wc * 32 + 8 * fq;
#pragma unroll
        for (int ai = 0; ai < 2; ++ai)
#pragma unroll
            for (int m = 0; m < 4; ++m) { bf16_t* rowp = base + (size_t)(row0 + ai * 128 + m * 16) * ldc + col0;
#pragma unroll
                for (int bj = 0; bj < 2; ++bj) { const f32x4 v0 = acc[ai][bj][m][0], v1 = acc[ai][bj][m][1];
                    u32x4 w; w.x = cvt_pk_bf16(v0[0], v0[1]); w.y = cvt_pk_bf16(v0[2], v0[3]); w.z = cvt_pk_bf16(v1[0], v1[1]); w.w = cvt_pk_bf16(v1[2], v1[3]);
                    *(u32x4*)(rowp + bj * 128) = w; } }
    }
};
struct EpiPool {
    static constexpr bool PERM = true; static constexpr bool DOUBLE = false;
    bf16_t* O; const float* scale;
    __device__ __forceinline__ void operator()(const AccT& acc, const Unit& u, int wr, int wc, int fr, int fq) const {
        const int row0 = u.pm * 256 + wr * 64 + fr, col0 = u.pn * 256 + wc * 32 + 8 * fq;
#pragma unroll
        for (int bj = 0; bj < 2; ++bj) { const f32x4 s0 = *(const f32x4*)(scale + col0 + bj * 128), s1 = *(const f32x4*)(scale + col0 + bj * 128 + 4);
#pragma unroll
            for (int ai = 0; ai < 2; ++ai)
#pragma unroll
                for (int m = 0; m < 4; ++m) { const f32x4 v0 = acc[ai][bj][m][0] * s0, v1 = acc[ai][bj][m][1] * s1;
                    u32x4 w; w.x = cvt_pk_bf16(v0[0], v0[1]); w.y = cvt_pk_bf16(v0[2], v0[3]); w.z = cvt_pk_bf16(v1[0], v1[1]); w.w = cvt_pk_bf16(v1[2], v1[3]);
                    *(u32x4*)(O + (size_t)(row0 + ai * 128 + m * 16) * PW + col0 + bj * 128) = w; } }
    }
};
template <int SECOND> struct EpiMerge {
    static constexpr bool PERM = true; static constexpr bool DOUBLE = false;
    const bf16_t* G; const bf16_t* Tin; bf16_t* Out;
    __device__ __forceinline__ void operator()(const AccT& acc, const Unit& u, int wr, int wc, int fr, int fq) const {
        const int row0 = u.pm * 256 + wr * 64 + fr, col0 = u.pn * 256 + wc * 32 + 8 * fq;
#pragma unroll
        for (int ai = 0; ai < 2; ++ai) {
            u32x4 gv[4][2], tv[4][2];
#pragma unroll
            for (int m = 0; m < 4; ++m)
#pragma unroll
                for (int bj = 0; bj < 2; ++bj) { const size_t off = (size_t)(row0 + ai * 128 + m * 16) * D + col0 + bj * 128;
                    gv[m][bj] = *(const u32x4*)(G + off); if (SECOND) tv[m][bj] = *(const u32x4*)(Tin + off); }
#pragma unroll
            for (int m = 0; m < 4; ++m)
#pragma unroll
                for (int bj = 0; bj < 2; ++bj) { const size_t off = (size_t)(row0 + ai * 128 + m * 16) * D + col0 + bj * 128;
                    const u32x4 g4 = gv[m][bj]; const f32x4 v0 = acc[ai][bj][m][0], v1 = acc[ai][bj][m][1];
                    float o[8];
                    o[0] = sigmoidf_(bf_lo(g4.x)) * v0[0]; o[1] = sigmoidf_(bf_hi(g4.x)) * v0[1]; o[2] = sigmoidf_(bf_lo(g4.y)) * v0[2]; o[3] = sigmoidf_(bf_hi(g4.y)) * v0[3];
                    o[4] = sigmoidf_(bf_lo(g4.z)) * v1[0]; o[5] = sigmoidf_(bf_hi(g4.z)) * v1[1]; o[6] = sigmoidf_(bf_lo(g4.w)) * v1[2]; o[7] = sigmoidf_(bf_hi(g4.w)) * v1[3];
                    if (SECOND) { const u32x4 t4 = tv[m][bj];
                        o[0] += bf_lo(t4.x); o[1] += bf_hi(t4.x); o[2] += bf_lo(t4.y); o[3] += bf_hi(t4.y); o[4] += bf_lo(t4.z); o[5] += bf_hi(t4.z); o[6] += bf_lo(t4.w); o[7] += bf_hi(t4.w); }
                    u32x4 w; w.x = cvt_pk_bf16(o[0], o[1]); w.y = cvt_pk_bf16(o[2], o[3]); w.z = cvt_pk_bf16(o[4], o[5]); w.w = cvt_pk_bf16(o[6], o[7]);
                    *(u32x4*)(Out + off) = w; }
        }
    }
};
template <int SECOND> struct EpiRes {
    static constexpr bool PERM = true; static constexpr bool DOUBLE = false;
    const float* xp; const float* xs; const bf16_t* xb; const float* gate; bf16_t* Xout;
    __device__ __forceinline__ void operator()(const AccT& acc, const Unit& u, int wr, int wc, int fr, int fq) const {
        const int row0 = u.pm * 256 + wr * 64 + fr, col0 = u.pn * 256 + wc * 32 + 8 * fq;
        const bool uni = u.pm < MP / 256;
        f32x4 gu[2][2];
        { const float* gp = gate + (size_t)(uni ? (u.pm >> 3) : 0) * MODW + col0;
#pragma unroll
          for (int bj = 0; bj < 2; ++bj)
#pragma unroll
            for (int n = 0; n < 2; ++n) gu[bj][n] = *(const f32x4*)(gp + bj * 128 + n * 4); }
#pragma unroll
        for (int ai = 0; ai < 2; ++ai)
#pragma unroll
        for (int mh = 0; mh < 2; ++mh) {
            f32x4 xv[2][2][2];
#pragma unroll
            for (int m2 = 0; m2 < 2; ++m2) { const int m = mh * 2 + m2; const int r = row0 + ai * 128 + m * 16;
                if (SECOND) {
#pragma unroll
                    for (int bj = 0; bj < 2; ++bj) { const u32x4 w = *(const u32x4*)(xb + (size_t)r * D + col0 + bj * 128);
                        xv[m2][bj][0] = (f32x4){bf_lo(w.x), bf_hi(w.x), bf_lo(w.y), bf_hi(w.y)}; xv[m2][bj][1] = (f32x4){bf_lo(w.z), bf_hi(w.z), bf_lo(w.w), bf_hi(w.w)}; }
                } else { const float* src = (r < MP ? xp + (size_t)r * D : xs + (size_t)(r - MP) * D) + col0;
#pragma unroll
                    for (int bj = 0; bj < 2; ++bj)
#pragma unroll
                        for (int n = 0; n < 2; ++n) xv[m2][bj][n] = *(const f32x4*)(src + bj * 128 + n * 4); } }
#pragma unroll
            for (int m2 = 0; m2 < 2; ++m2) { const int m = mh * 2 + m2; const int r = row0 + ai * 128 + m * 16; bf16_t* op = Xout + (size_t)r * D + col0;
                const float* gp = gate + (size_t)cond_of_row(r) * MODW + col0;
#pragma unroll
                for (int bj = 0; bj < 2; ++bj) { const f32x4 g0 = uni ? gu[bj][0] : *(const f32x4*)(gp + bj * 128), g1 = uni ? gu[bj][1] : *(const f32x4*)(gp + bj * 128 + 4);
                    const f32x4 o0 = xv[m2][bj][0] * ALPHA + g0 * acc[ai][bj][m][0], o1 = xv[m2][bj][1] * ALPHA + g1 * acc[ai][bj][m][1];
                    u32x4 w; w.x = cvt_pk_bf16(o0[0], o0[1]); w.y = cvt_pk_bf16(o0[2], o0[3]); w.z = cvt_pk_bf16(o1[0], o1[1]); w.w = cvt_pk_bf16(o1[2], o1[3]);
                    *(u32x4*)(op + bj * 128) = w; } }
        }
    }
};
struct EpiPartial {
    static constexpr bool PERM = true; static constexpr bool DOUBLE = false;
    float* part;
    __device__ __forceinline__ void operator()(const AccT& acc, const Unit& u, int wr, int wc, int fr, int fq) const {
        const int row0 = (u.pm - MP / 256) * 256 + wr * 64 + fr, col0 = u.pn * 256 + wc * 32 + 8 * fq;
        float* base = part + (size_t)u.kb * MS * D;
#pragma unroll
        for (int ai = 0; ai < 2; ++ai)
#pragma unroll
            for (int m = 0; m < 4; ++m) { float* rowp = base + (size_t)(row0 + ai * 128 + m * 16) * D + col0;
#pragma unroll
                for (int bj = 0; bj < 2; ++bj) { *(f32x4*)(rowp + bj * 128) = acc[ai][bj][m][0]; *(f32x4*)(rowp + bj * 128 + 4) = acc[ai][bj][m][1]; } }
    }
};
struct EpiSwiglu {
    static constexpr bool PERM = true; static constexpr bool DOUBLE = false;
    bf16_t* HM;
    __device__ __forceinline__ void operator()(const AccT& acc, const Unit& u, int wr, int wc, int fr, int fq) const {
        const int row0 = u.pm * 256 + wr * 64 + fr, col0 = u.pn * 128 + wc * 32 + 8 * fq;
#pragma unroll
        for (int ai = 0; ai < 2; ++ai)
#pragma unroll
            for (int m = 0; m < 4; ++m) { float o[8];
#pragma unroll
                for (int n = 0; n < 2; ++n)
#pragma unroll
                    for (int j = 0; j < 4; ++j) { const float gt = acc[ai][0][m][n][j], up = acc[ai][1][m][n][j]; o[n * 4 + j] = gt * sigmoidf_(gt) * up; }
                u32x4 w; w.x = cvt_pk_bf16(o[0], o[1]); w.y = cvt_pk_bf16(o[2], o[3]); w.z = cvt_pk_bf16(o[4], o[5]); w.w = cvt_pk_bf16(o[6], o[7]);
                *(u32x4*)(HM + (size_t)(row0 + ai * 128 + m * 16) * DFF + col0) = w; }
    }
};

#define XB_TMO      128
#define XB_XCNT(j)  (256  + 64 * (j))
#define XB_XSUB(j)  (1280 + 64 * (j))
#define XB_XGEN(j)  (2304 + 64 * (j))
#define XB_TOP      3328
#define XB_TOPGEN   3392
#define XCD_BAR_WORDS 3456
#define XB_SPIN_CAP (1u << 18)
__device__ __forceinline__ unsigned xb_ld(unsigned* p)              { return __hip_atomic_load(p, __ATOMIC_RELAXED, __HIP_MEMORY_SCOPE_AGENT); }
__device__ __forceinline__ unsigned xb_add(unsigned* p, unsigned v) { return __hip_atomic_fetch_add(p, v, __ATOMIC_RELAXED, __HIP_MEMORY_SCOPE_AGENT); }
__device__ __forceinline__ unsigned xb_xcc_id() { return (unsigned)__builtin_amdgcn_s_getreg((3 << 11) | 20) & 0xFu; }
#define XB_SPIN(cond, bar) do { unsigned _sp = 0; while (cond) { __builtin_amdgcn_s_sleep(1); \
    if ((++_sp & 255u) == 0u) { if (xb_ld(&(bar)[XB_TMO])) break; if (_sp > XB_SPIN_CAP) { atomicAdd(&(bar)[XB_TMO], 1u); break; } } } } while (0)
struct XcdBarrier { unsigned* bar; unsigned x; volatile LAS unsigned* st; };
__device__ __forceinline__ XcdBarrier xcd_barrier_post(unsigned* bar, volatile LAS unsigned* st) {
    XcdBarrier b; b.bar = bar; b.x = xb_xcc_id(); b.st = st;
    if (threadIdx.x == 0) (void)xb_add(&bar[XB_XCNT(b.x)], 1u);
    return b;
}
__device__ __forceinline__ void xcd_barrier_complete(unsigned* bar, unsigned x, unsigned& nloc, unsigned& nx) {
    const unsigned G = gridDim.x * gridDim.y * gridDim.z;
    unsigned sum, cnt, mine, sp = 0u;
    for (;;) {
        sum = 0u; cnt = 0u; mine = 0u;
#pragma unroll
        for (unsigned j = 0; j < 16; ++j) { const unsigned c = xb_ld(&bar[XB_XCNT(j)]); sum += c; cnt += (c > 0u) ? 1u : 0u; mine = (j == x) ? c : mine; }
        if (sum == G) break;
        __builtin_amdgcn_s_sleep(1);
        if ((++sp & 255u) == 0u) { if (xb_ld(&bar[XB_TMO])) break; if (sp > XB_SPIN_CAP) { atomicAdd(&bar[XB_TMO], 1u); break; } }
    }
    nloc = mine > 0u ? mine : 1u; nx = cnt > 0u ? cnt : 1u;
}
__device__ __forceinline__ void xcd_barrier(const XcdBarrier& b) {
    asm volatile("s_waitcnt vmcnt(0)" ::: "memory");
    __syncthreads();
    if (threadIdx.x == 0) {
        unsigned* bar = b.bar;
        __builtin_amdgcn_s_waitcnt(0);
        unsigned nloc = b.st[0], nx = b.st[1];
        if (nloc == 0u) { xcd_barrier_complete(bar, b.x, nloc, nx); b.st[0] = nloc; b.st[1] = nx; }
        const unsigned old = xb_add(&bar[XB_XSUB(b.x)], 1u);
        const unsigned gen = old / nloc;
        if (old + 1u == (gen + 1u) * nloc) {
            __builtin_amdgcn_fence(__ATOMIC_RELEASE, "agent");
            asm volatile("s_waitcnt vmcnt(0)" ::: "memory");
            const unsigned og = xb_add(&bar[XB_TOP], 1u);
            const unsigned tg = og / nx;
            if (og + 1u == (tg + 1u) * nx) xb_add(&bar[XB_TOPGEN], 1u);
            else XB_SPIN(xb_ld(&bar[XB_TOPGEN]) == tg, bar);
            __builtin_amdgcn_fence(__ATOMIC_ACQUIRE, "agent");
            xb_add(&bar[XB_XGEN(b.x)], 1u);
            asm volatile("s_waitcnt vmcnt(0)" ::: "memory");
        } else {
            XB_SPIN(xb_ld(&bar[XB_XGEN(b.x)]) == gen, bar);
            __builtin_amdgcn_fence(__ATOMIC_ACQUIRE, "agent");
            asm volatile("s_waitcnt vmcnt(0)" ::: "memory");
        }
    }
    __syncthreads();
}

struct KArgs { const float* in[26]; float* out; unsigned char* ws; int ph_lo, ph_hi; };

struct Frame {
    LAS unsigned char* lds;
    const float* const* in; float* out; unsigned char* ws;
    int tid, lane, wid, G, bid;
};

__device__ __forceinline__ void transpose_tile(LAS float* tile, const float* src, int ldsrc, int k0, int c0, bf16_t* dst, int K, int n0, int tid) {
    { const int i = tid >> 3, j8 = (tid & 7) * 8; const float* sp = src + (size_t)(k0 + i) * ldsrc + c0 + j8;
      const f32x4 a = *(const f32x4*)sp, b = *(const f32x4*)(sp + 4); LAS float* tp = tile + i * 65 + j8;
      tp[0] = a[0]; tp[1] = a[1]; tp[2] = a[2]; tp[3] = a[3]; tp[4] = b[0]; tp[5] = b[1]; tp[6] = b[2]; tp[7] = b[3]; }
    __syncthreads();
    { const int n = tid >> 3, k8 = (tid & 7) * 8; const LAS float* tp = tile + k8 * 65 + n;
      u32x4 w; w.x = cvt_pk_bf16(tp[0], tp[65]); w.y = cvt_pk_bf16(tp[130], tp[195]); w.z = cvt_pk_bf16(tp[260], tp[325]); w.w = cvt_pk_bf16(tp[390], tp[455]);
      *(u32x4*)(dst + (size_t)(n0 + n) * K + k0 + k8) = w; }
    __syncthreads();
}

__device__ __forceinline__ void phase_prologue(const Frame& F) {
    const int tid = F.tid;
    REP(40) {
        LAS float* sT = (LAS float*)F.lds;
        LAS float* red = (LAS float*)(F.lds + 53248);
        float* MOD = (float*)(F.ws + WS_MOD);
        const float* cp = F.in[2]; const float* cs = F.in[3]; const float* wada = F.in[8]; const float* bada = F.in[9];
        const int cgp = tid % 12, cdg = (tid / 12) % 4, kl = tid / 48;
        for (int cb = F.bid; cb < 256; cb += F.G) {
            typedef float f32x2 __attribute__((ext_vector_type(2)));
            f32x2 acc[12][2];
#pragma unroll
            for (int c = 0; c < 12; ++c) { acc[c][0] = (f32x2){0.f, 0.f}; acc[c][1] = (f32x2){0.f, 0.f}; }
            for (int kc = 0; kc < 8; ++kc) {
                __syncthreads();
                for (int i = 0; i < 24; ++i) { const int idx = tid + 512 * i, cd = idx >> 8, kk = idx & 255;
                    const float cv = cd < 16 ? cp[cd * D + kc * 256 + kk] : cs[(cd - 16) * D + kc * 256 + kk];
                    sT[kk * 52 + cd] = cv * sigmoidf_(cv); }
                __syncthreads();
                if (tid < 480) {
#pragma unroll 2
                    for (int kk = kl; kk < 256; kk += 10) {
                        const f32x4 w4 = *(const f32x4*)(wada + (size_t)(kc * 256 + kk) * MODW + 48 * cb + 4 * cgp);
                        const f32x2 w01 = (f32x2){w4[0], w4[1]}, w23 = (f32x2){w4[2], w4[3]};
                        const LAS f32x4* sp = (const LAS f32x4*)(sT + kk * 52 + 12 * cdg);
                        const f32x4 s0 = sp[0], s1 = sp[1], s2 = sp[2];
#pragma unroll
                        for (int c = 0; c < 4; ++c) {
                            acc[c][0] = __builtin_elementwise_fma((f32x2){s0[c], s0[c]}, w01, acc[c][0]); acc[c][1] = __builtin_elementwise_fma((f32x2){s0[c], s0[c]}, w23, acc[c][1]);
                            acc[4 + c][0] = __builtin_elementwise_fma((f32x2){s1[c], s1[c]}, w01, acc[4 + c][0]); acc[4 + c][1] = __builtin_elementwise_fma((f32x2){s1[c], s1[c]}, w23, acc[4 + c][1]);
                            acc[8 + c][0] = __builtin_elementwise_fma((f32x2){s2[c], s2[c]}, w01, acc[8 + c][0]); acc[8 + c][1] = __builtin_elementwise_fma((f32x2){s2[c], s2[c]}, w23, acc[8 + c][1]); }
                    }
                }
            }
            if (tid < 480) {
#pragma unroll
                for (int c = 0; c < 12; ++c) *(LAS f32x4*)(red + (kl * 48 + 12 * cdg + c) * 48 + 4 * cgp) = (f32x4){acc[c][0][0], acc[c][0][1], acc[c][1][0], acc[c][1][1]};
            }
            __syncthreads();
            for (int o = tid; o < 2304; o += 512) { const int cd = o / 48, col = o % 48; float s = bada[48 * cb + col];
#pragma unroll
                for (int k = 0; k < 10; ++k) s += red[(k * 48 + cd) * 48 + col];
                MOD[(size_t)cd * MODW + 48 * cb + col] = s; }
            __syncthreads();
        }
    }
    REP(41) {
        LAS float* tile = (LAS float*)F.lds;
        constexpr int T0 = 32 * 208, T1 = T0 + 64, T2 = T1 + 512, T3 = T2 + 1024, T4 = T3 + 1024, T5 = T4 + 32 * 176, T6 = T5 + 88 * 32;
        const int i = tid >> 3, j8 = (tid & 7) * 8;
        for (int Tb = F.bid * 4; Tb < T6; Tb += F.G * 4) {
            const float* src[4]; bf16_t* dst[4]; bool ok[4]; f32x4 va[4], vb[4];
#pragma unroll
            for (int q = 0; q < 4; ++q) { const int T = Tb + q; ok[q] = T < T6;
                const float* sp; int ldsrc, k0, c0, K, n0; bf16_t* dp;
                if (T < T0) { const int nt = T % 208, kt = T / 208; n0 = nt * 64; c0 = n0 < 9216 ? n0 : n0 + 16; sp = F.in[10]; ldsrc = NIN; k0 = kt * 64; dp = (bf16_t*)(F.ws + WS_WIN); K = D; }
                else if (T < T1) { const int t = T - T0, g = t >> 4, kt = (t >> 2) & 3, nt = t & 3; sp = F.in[13] + (size_t)g * 65536; ldsrc = 256; k0 = kt * 64; c0 = nt * 64; dp = (bf16_t*)(F.ws + WS_WPOOL) + (size_t)g * 65536; K = 256; n0 = nt * 64; }
                else if (T < T2) { const int t = T - T1, nt = t & 31, kt = t >> 5; sp = F.in[16]; ldsrc = D; k0 = kt * 64; c0 = nt * 64; dp = (bf16_t*)(F.ws + WS_WPA); K = PW; n0 = nt * 64; }
                else if (T < T3) { const int t = T - T2, nt = t & 31, kt = t >> 5; sp = F.in[17]; ldsrc = D; k0 = kt * 64; c0 = nt * 64; dp = (bf16_t*)(F.ws + WS_WPB); K = D; n0 = nt * 64; }
                else if (T < T4) { const int t = T - T3, nt = t & 31, kt = t >> 5; sp = F.in[18]; ldsrc = D; k0 = kt * 64; c0 = nt * 64; dp = (bf16_t*)(F.ws + WS_WOUT); K = D; n0 = nt * 64; }
                else if (T < T5) { const int t = T - T4, nt = t % 176, kt = t / 176; const int pn = nt >> 2, qq = nt & 3; sp = qq < 2 ? F.in[21] : F.in[22]; ldsrc = DFF; k0 = kt * 64; c0 = 128 * pn + 64 * (qq & 1); dp = (bf16_t*)(F.ws + WS_WGU); K = D; n0 = nt * 64; }
                else { const int t = (ok[q] ? T : T6 - 1) - T5, nt = t & 31, kt = t >> 5; sp = F.in[23]; ldsrc = D; k0 = kt * 64; c0 = nt * 64; dp = (bf16_t*)(F.ws + WS_WDOWN); K = DFF; n0 = nt * 64; }
                src[q] = sp + (size_t)(k0 + i) * ldsrc + c0 + j8;
                dst[q] = dp + (size_t)(n0 + i) * K + k0 + j8;
                va[q] = *(const f32x4*)src[q]; vb[q] = *(const f32x4*)(src[q] + 4); }
#pragma unroll
            for (int q = 0; q < 4; ++q) { LAS float* tp = tile + q * (64 * 65) + i * 65 + j8;
                tp[0] = va[q][0]; tp[1] = va[q][1]; tp[2] = va[q][2]; tp[3] = va[q][3]; tp[4] = vb[q][0]; tp[5] = vb[q][1]; tp[6] = vb[q][2]; tp[7] = vb[q][3]; }
            __syncthreads();
#pragma unroll
            for (int q = 0; q < 4; ++q) { const LAS float* tp = tile + q * (64 * 65) + j8 * 65 + i;
                u32x4 w; w.x = cvt_pk_bf16(tp[0], tp[65]); w.y = cvt_pk_bf16(tp[130], tp[195]); w.z = cvt_pk_bf16(tp[260], tp[325]); w.w = cvt_pk_bf16(tp[390], tp[455]);
                if (ok[q]) *(u32x4*)dst[q] = w; }
            __syncthreads();
        }
    }
}

__device__ __forceinline__ void phase_ln_in(const Frame& F) {
    LAS float* wgT = (LAS float*)F.lds;
    const float* win = F.in[10];
    for (int k = F.tid; k < D; k += NTHREADS) { const float* sp = win + (size_t)k * NIN + 9216;
#pragma unroll
        for (int q = 0; q < 4; ++q) { const f32x4 v = *(const f32x4*)(sp + 4 * q); wgT[(4 * q + 0) * D + k] = v[0]; wgT[(4 * q + 1) * D + k] = v[1]; wgT[(4 * q + 2) * D + k] = v[2]; wgT[(4 * q + 3) * D + k] = v[3]; } }
    __syncthreads();
    const float* MOD = (const float*)(F.ws + WS_MOD); float* GATES = (float*)(F.ws + WS_GATES); bf16_t* U = (bf16_t*)(F.ws + WS_U);
    const int lane = F.lane;
    const int gidx = ((lane >> 5) & 1) * 8 + ((lane >> 4) & 1) * 4 + ((lane >> 3) & 1) * 2 + ((lane >> 2) & 1);
    const float bias = gidx < 8 ? F.in[11][gidx] : F.in[12][gidx - 8];
    const bool b5 = (lane & 32) != 0, b4 = (lane & 16) != 0, b3 = (lane & 8) != 0, b2 = (lane & 4) != 0;
    for (int r = F.bid * 8 + F.wid; r < M; r += F.G * 8) {
        const float* xr = r < MP ? F.in[0] + (size_t)r * D : F.in[1] + (size_t)(r - MP) * D; const int cd = cond_of_row(r);
        f32x4 xv[8]; float s = 0.f;
#pragma unroll
        for (int j = 0; j < 8; ++j) { xv[j] = *(const f32x4*)(xr + j * 256 + lane * 4); s += (xv[j][0] + xv[j][1]) + (xv[j][2] + xv[j][3]); }
        const float mu = wave_sum(s) * (1.0f / D); float q = 0.f;
#pragma unroll
        for (int j = 0; j < 8; ++j) { xv[j] = xv[j] - mu; q += (xv[j][0] * xv[j][0] + xv[j][1] * xv[j][1]) + (xv[j][2] * xv[j][2] + xv[j][3] * xv[j][3]); }
        const float rstd = rsqrtf(wave_sum(q) * (1.0f / D) + LN_EPS);
        const float* sh = MOD + (size_t)cd * MODW; const float* sc = sh + D;
        float ga[16];
#pragma unroll
        for (int g = 0; g < 16; ++g) ga[g] = 0.f;
#pragma unroll
        for (int j = 0; j < 8; ++j) { const int e = j * 256 + lane * 4; const f32x4 scv = *(const f32x4*)(sc + e), shv = *(const f32x4*)(sh + e);
            const f32x4 u = xv[j] * rstd * (scv + 1.0f) + shv;
            u32x2 w; w.x = cvt_pk_bf16(u[0], u[1]); w.y = cvt_pk_bf16(u[2], u[3]); *(u32x2*)(U + (size_t)r * D + e) = w;
#pragma unroll
            for (int g = 0; g < 16; ++g) { const f32x4 wv = *(const LAS f32x4*)(wgT + g * D + e); ga[g] += (u[0] * wv[0] + u[1] * wv[1]) + (u[2] * wv[2] + u[3] * wv[3]); } }
        float v8[8], v4[4], v2[2];
#pragma unroll
        for (int i = 0; i < 8; ++i) { const float mine = b5 ? ga[i + 8] : ga[i], oth = b5 ? ga[i] : ga[i + 8]; v8[i] = mine + __shfl_xor(oth, 32); }
#pragma unroll
        for (int i = 0; i < 4; ++i) { const float mine = b4 ? v8[i + 4] : v8[i], oth = b4 ? v8[i] : v8[i + 4]; v4[i] = mine + __shfl_xor(oth, 16); }
#pragma unroll
        for (int i = 0; i < 2; ++i) { const float mine = b3 ? v4[i + 2] : v4[i], oth = b3 ? v4[i] : v4[i + 2]; v2[i] = mine + __shfl_xor(oth, 8); }
        float v1 = (b2 ? v2[1] : v2[0]) + __shfl_xor(b2 ? v2[0] : v2[1], 4);
        v1 += __shfl_xor(v1, 2); v1 += __shfl_xor(v1, 1);
        if ((lane & 3) == 0) GATES[(size_t)r * 16 + gidx] = v1 + bias;
    }
    __syncthreads();
}

__device__ __forceinline__ void acc_bf8(float (&sum)[8], const u32x4 v) {
    sum[0] += bf_lo(v.x); sum[1] += bf_hi(v.x); sum[2] += bf_lo(v.y); sum[3] += bf_hi(v.y); sum[4] += bf_lo(v.z); sum[5] += bf_hi(v.z); sum[6] += bf_lo(v.w); sum[7] += bf_hi(v.w);
}
template <int W> __device__ __forceinline__ void pool_group(const Frame& F, int g) {
    const bf16_t* P = (const bf16_t*)((unsigned char*)F.out + SZ_TOK); bf16_t* Y = (bf16_t*)((unsigned char*)F.out + SZ_TOK + (size_t)M * PW * 2);
    const float* spool = F.in[4];
    for (int idx = F.bid * NTHREADS + F.tid; idx < M * 32; idx += F.G * NTHREADS) {
        const int r = idx >> 5, c = g * 256 + (idx & 31) * 8;
        const bool prompt = r < MP; const int b = prompt ? (r >> 11) : ((r - MP) >> 5), l = prompt ? (r & 2047) : ((r - MP) & 31);
        float sum[8], tok[8];
        const bf16_t* pr = P + (size_t)r * PW + c;
        u32x4 v[W];
#pragma unroll
        for (int j = 0; j < W; ++j) v[j] = (l - j >= 0) ? *(const u32x4*)(pr - (size_t)j * PW) : (u32x4){0u, 0u, 0u, 0u};
        tok[0] = bf_lo(v[0].x); tok[1] = bf_hi(v[0].x); tok[2] = bf_lo(v[0].y); tok[3] = bf_hi(v[0].y); tok[4] = bf_lo(v[0].z); tok[5] = bf_hi(v[0].z); tok[6] = bf_lo(v[0].w); tok[7] = bf_hi(v[0].w);
#pragma unroll
        for (int q = 0; q < 8; ++q) sum[q] = tok[q];
#pragma unroll
        for (int j = 1; j < W; ++j) acc_bf8(sum, v[j]);
        if (!prompt && l < W - 1) {
            for (int j = l + 1; j < W; ++j) { const float* sp = spool + ((size_t)b * 15 + 15 + (l - j)) * PW + c; const f32x4 x0 = *(const f32x4*)sp, x1 = *(const f32x4*)(sp + 4);
                sum[0] += x0[0]; sum[1] += x0[1]; sum[2] += x0[2]; sum[3] += x0[3]; sum[4] += x1[0]; sum[5] += x1[1]; sum[6] += x1[2]; sum[7] += x1[3]; } }
        const float inv = 1.0f / (float)(prompt ? (l + 1 < W ? l + 1 : W) : W);
        u32x4 o; o.x = cvt_pk_bf16(sum[0] * inv - tok[0], sum[1] * inv - tok[1]); o.y = cvt_pk_bf16(sum[2] * inv - tok[2], sum[3] * inv - tok[3]);
        o.z = cvt_pk_bf16(sum[4] * inv - tok[4], sum[5] * inv - tok[5]); o.w = cvt_pk_bf16(sum[6] * inv - tok[6], sum[7] * inv - tok[7]);
        *(u32x4*)(Y + (size_t)r * PW + c) = o;
        float* sp = nullptr;
        if (prompt && l >= SEQ - 15) sp = F.out + OUT_POOLP + ((size_t)b * 15 + (l - (SEQ - 15))) * PW + c;
        if (!prompt && l >= DSEQ - 15) sp = F.out + OUT_POOLS + ((size_t)b * 15 + (l - (DSEQ - 15))) * PW + c;
        if (sp) { *(f32x4*)sp = (f32x4){tok[0], tok[1], tok[2], tok[3]}; *(f32x4*)(sp + 4) = (f32x4){tok[4], tok[5], tok[6], tok[7]}; }
    }
}
__device__ __forceinline__ void phase_pool(const Frame& F) { pool_group<2>(F, 0); pool_group<4>(F, 1); pool_group<8>(F, 2); pool_group<16>(F, 3); }

template <int CTRL, int ROW_MASK> __device__ __forceinline__ float dpp_f(float old, float src) {
    return __int_as_float(__builtin_amdgcn_update_dpp(__float_as_int(old), __float_as_int(src), CTRL, ROW_MASK, 0xF, false));
}
__device__ __forceinline__ float row16_sum(float v) {
    v += dpp_f<0xB1, 0xF>(v, v); v += dpp_f<0x4E, 0xF>(v, v); v += dpp_f<0x141, 0xF>(v, v); v += dpp_f<0x140, 0xF>(v, v); return v;
}
__device__ __forceinline__ float oct_sum(float v) {
    v += dpp_f<0xB1, 0xF>(v, v); v += dpp_f<0x4E, 0xF>(v, v); v += dpp_f<0x141, 0xF>(v, v); return v;
}
__device__ __forceinline__ float wave_incl_sum(float v, int) {
    v += dpp_f<0x111, 0xF>(0.f, v); v += dpp_f<0x112, 0xF>(0.f, v); v += dpp_f<0x114, 0xF>(0.f, v); v += dpp_f<0x118, 0xF>(0.f, v);
    v += dpp_f<0x142, 0xA>(0.f, v); v += dpp_f<0x143, 0xC>(0.f, v); return v;
}
__device__ __forceinline__ float wave_incl_max(float v, int) {
    const float ninf = -INFINITY;
    v = fmaxf(v, dpp_f<0x111, 0xF>(ninf, v)); v = fmaxf(v, dpp_f<0x112, 0xF>(ninf, v)); v = fmaxf(v, dpp_f<0x114, 0xF>(ninf, v)); v = fmaxf(v, dpp_f<0x118, 0xF>(ninf, v));
    v = fmaxf(v, dpp_f<0x142, 0xA>(ninf, v)); v = fmaxf(v, dpp_f<0x143, 0xC>(ninf, v)); return v;
}

#define MLSTM_LOAD(stp) do { const size_t rb_ = (size_t)(row0 + (stp) * 64); \
    const bf16_t* qrow_ = Qb + rb_ * D + h * HD; const bf16_t* krow_ = Kb + rb_ * D + h * HD; const bf16_t* vrow_ = Vb + rb_ * D + h * HD + eh * 128; const float* grow_ = GATES + rb_ * 16 + h; \
    _Pragma("unroll") for (int i_ = 0; i_ < 4; ++i_) { \
        if ((int)(offqk[i_] >> 11) < L) { qreg[i_] = *(const u32x4*)(qrow_ + offqk[i_]); kreg[i_] = *(const u32x4*)(krow_ + offqk[i_]); } \
        else { qreg[i_] = (u32x4){0u, 0u, 0u, 0u}; kreg[i_] = (u32x4){0u, 0u, 0u, 0u}; } } \
    _Pragma("unroll") for (int i_ = 0; i_ < 2; ++i_) { \
        if (lane < L) vreg[i_] = *(const u32x4*)(vrow_ + offv + i_ * 8); else vreg[i_] = (u32x4){0u, 0u, 0u, 0u}; } \
    if (lane < L) { igr = grow_[lane * 16]; fgr = grow_[lane * 16 + 8]; } else { igr = -INFINITY; fgr = 0.f; } } while (0)

__device__ __forceinline__ void mlstm_item(LAS unsigned char* lds, const bf16_t* Qb, const bf16_t* Kb, const bf16_t* Vb, bf16_t* Hb, const float* GATES,
                           int row0, int nsteps, int L, int h, int eh, const float* C0, const float* n0, float m_init,
                           float* C_out, float* n_out, float* m_out) {
    const int tid = threadIdx.x, wid = __builtin_amdgcn_readfirstlane(tid >> 6), lane = tid & 63, fr = lane & 15, fq = lane >> 4;
    constexpr int QP = 8 * 33, KP = 8 * 34, TP = 8 * 10;
    LAS bf16_t* Qs = (LAS bf16_t*)lds;
    LAS bf16_t* Ks = (LAS bf16_t*)(lds + 33792);
    LAS bf16_t* Kt = (LAS bf16_t*)(lds + 68608);
    LAS bf16_t* Vt = (LAS bf16_t*)(lds + 109568);
    LAS bf16_t* Ss = (LAS bf16_t*)(lds + 130048);
    LAS float* nS = (LAS float*)(lds + 140288);
    LAS float* rsS = (LAS float*)(lds + 142336);
    LAS float* qnS = (LAS float*)(lds + 142848);
    f32x4 Cacc[16];
    if (C0) { const float* cp = C0 + (size_t)(4 * fq) * HD + eh * 128 + 16 * wid + fr;
#pragma unroll
      for (int t = 0; t < 16; ++t) {
#pragma unroll
        for (int i = 0; i < 4; ++i) Cacc[t][i] = cp[i * HD];
        cp += 16 * HD; asm volatile("" : "+v"(cp)); } }
    else {
#pragma unroll
      for (int t = 0; t < 16; ++t) Cacc[t] = (f32x4){0.f, 0.f, 0.f, 0.f}; }
    if (tid < 256) nS[tid] = n0 ? n0[tid] : 0.f;
    float m_prev = m_init; int p = 0;
    u32x4 qreg[4], kreg[4], vreg[2]; float igr, fgr;
    unsigned offqk[4];
#pragma unroll
    for (int i = 0; i < 4; ++i) { const int pp = tid + 512 * i; offqk[i] = (unsigned)((pp >> 5) * D + (pp & 31) * 8); }
    const unsigned offv = (unsigned)(lane * D + wid * 16);
    MLSTM_LOAD(0);
    for (int st = 0; st < nsteps; ++st) {
        const int rbase = row0 + st * 64;
        const float lf = lane < L ? (fminf(fgr, 0.f) - log1pf(__expf(-fabsf(fgr)))) : 0.f;
        const float bcum = wave_incl_sum(lf, lane);
        const float gsc = igr - bcum;
        const float Mv = fmaxf(m_prev, wave_incl_max(gsc, lane));
        const float M63 = __int_as_float(__builtin_amdgcn_readlane(__float_as_int(Mv), 63)), b63 = __int_as_float(__builtin_amdgcn_readlane(__float_as_int(bcum), 63));
        const float wsv = __expf(gsc - M63) * 0.0625f;
        const float winter = __expf(m_prev - Mv);
        const float eneg = __expf(-(bcum + Mv));
        const float decay = __expf(m_prev - M63);
        const float m_new = b63 + M63;
#pragma unroll
        for (int i = 0; i < 4; ++i) { const int pp = tid + 512 * i, s = pp >> 5, c8 = (pp & 31) * 8; *(LAS u32x4*)(Qs + s * QP + c8) = qreg[i]; *(LAS u32x4*)(Ks + s * KP + c8) = kreg[i]; }
#pragma unroll
        for (int i = 0; i < 2; ++i) { const int eg = wid * 2 + i; const u32x4 v = vreg[i]; LAS bf16_t* vp = Vt + (eg * 8) * TP + lane;
            vp[0] = (bf16_t)(v.x & 0xffffu); vp[1 * TP] = (bf16_t)(v.x >> 16); vp[2 * TP] = (bf16_t)(v.y & 0xffffu); vp[3 * TP] = (bf16_t)(v.y >> 16);
            vp[4 * TP] = (bf16_t)(v.z & 0xffffu); vp[5 * TP] = (bf16_t)(v.z >> 16); vp[6 * TP] = (bf16_t)(v.w & 0xffffu); vp[7 * TP] = (bf16_t)(v.w >> 16); }
        __syncthreads();
#pragma unroll
        for (int i = 0; i < 4; ++i) { const int dg = wid * 4 + i; const u32x4 kv = *(const LAS u32x4*)(Ks + lane * KP + dg * 8); LAS bf16_t* kp = Kt + (dg * 8) * TP + lane;
            const unsigned w0 = cvt_pk_bf16(bf_lo(kv.x) * wsv, bf_hi(kv.x) * wsv), w1 = cvt_pk_bf16(bf_lo(kv.y) * wsv, bf_hi(kv.y) * wsv);
            const unsigned w2 = cvt_pk_bf16(bf_lo(kv.z) * wsv, bf_hi(kv.z) * wsv), w3 = cvt_pk_bf16(bf_lo(kv.w) * wsv, bf_hi(kv.w) * wsv);
            kp[0] = (bf16_t)(w0 & 0xffffu); kp[1 * TP] = (bf16_t)(w0 >> 16); kp[2 * TP] = (bf16_t)(w1 & 0xffffu); kp[3 * TP] = (bf16_t)(w1 >> 16);
            kp[4 * TP] = (bf16_t)(w2 & 0xffffu); kp[5 * TP] = (bf16_t)(w2 >> 16); kp[6 * TP] = (bf16_t)(w3 & 0xffffu); kp[7 * TP] = (bf16_t)(w3 >> 16); }
        __builtin_amdgcn_sched_barrier(0);
        REP(60) {
            const int lt = wid >> 1, st0 = (wid & 1) * 2;
            f32x4 sacc[2]; sacc[0] = (f32x4){0.f, 0.f, 0.f, 0.f}; sacc[1] = sacc[0];
#pragma unroll
            for (int hk = 0; hk < 2; ++hk) { bf16x8 af[4], bfr[4][2];
#pragma unroll
                for (int k4 = 0; k4 < 4; ++k4) { const int kk = hk * 4 + k4; af[k4] = *(const LAS bf16x8*)(Qs + (16 * lt + fr) * QP + 32 * kk + 8 * fq);
#pragma unroll
                    for (int t2 = 0; t2 < 2; ++t2) bfr[k4][t2] = *(const LAS bf16x8*)(Ks + (16 * (st0 + t2) + fr) * KP + 32 * kk + 8 * fq); }
                __builtin_amdgcn_sched_barrier(0);
#pragma unroll
                for (int k4 = 0; k4 < 4; ++k4)
#pragma unroll
                    for (int t2 = 0; t2 < 2; ++t2) sacc[t2] = mfma16(af[k4], bfr[k4][t2], sacc[t2]);
                __builtin_amdgcn_sched_barrier(0); }
            float Ml[4], rs[4];
#pragma unroll
            for (int i = 0; i < 4; ++i) { Ml[i] = __shfl(Mv, 16 * lt + 4 * fq + i); rs[i] = 0.f; }
#pragma unroll
            for (int t2 = 0; t2 < 2; ++t2) { const int s = 16 * (st0 + t2) + fr; const float gs = __shfl(gsc, s);
#pragma unroll
                for (int i = 0; i < 4; ++i) { const int l = 16 * lt + 4 * fq + i; const float val = (s <= l) ? sacc[t2][i] * 0.0625f * __expf(gs - Ml[i]) : 0.f;
                    rs[i] += val; Ss[l * TP + s] = (bf16_t)(cvt_pk_bf16(val, 0.f) & 0xffffu); } }
#pragma unroll
            for (int i = 0; i < 4; ++i) { const float v = row16_sum(rs[i]);
                if (fr == 0) rsS[(wid & 1) * 64 + 16 * lt + 4 * fq + i] = v; }
        }
        __builtin_amdgcn_sched_barrier(0);
        {
            const int l = 8 * wid + (lane >> 3), part = lane & 7; float a = 0.f;
#pragma unroll
            for (int j = 0; j < 4; ++j) { const u32x4 qv = *(const LAS u32x4*)(Qs + l * QP + 32 * part + 8 * j);
                const f32x4 n0v = *(const LAS f32x4*)(nS + p * 256 + 32 * part + 8 * j), n1v = *(const LAS f32x4*)(nS + p * 256 + 32 * part + 8 * j + 4);
                a += bf_lo(qv.x) * n0v[0] + bf_hi(qv.x) * n0v[1] + bf_lo(qv.y) * n0v[2] + bf_hi(qv.y) * n0v[3] + bf_lo(qv.z) * n1v[0] + bf_hi(qv.z) * n1v[1] + bf_lo(qv.w) * n1v[2] + bf_hi(qv.w) * n1v[3]; }
            a = oct_sum(a);
            if (part == 0) qnS[l] = a;
        }
        __builtin_amdgcn_sched_barrier(0);
        f32x4 oacc[4];
#pragma unroll
        for (int i = 0; i < 4; ++i) oacc[i] = (f32x4){0.f, 0.f, 0.f, 0.f};
        REP(61) {
            if (REPEAT_PHASE == 61) { asm volatile("" : "+v"(oacc[0]), "+v"(oacc[1]), "+v"(oacc[2]), "+v"(oacc[3]));
#pragma unroll
                for (int i = 0; i < 4; ++i) oacc[i] = (f32x4){0.f, 0.f, 0.f, 0.f}; }
            bf16x8 qf[2][4];
#define QC_LOAD(buf, kk_) do { _Pragma("unroll") for (int lt2 = 0; lt2 < 4; ++lt2) { const LAS bf16_t* qp = Qs + (16 * lt2 + fr) * QP + 32 * (kk_) + 4 * fq; \
                const LAS bf16_t* qp2 = qp + 16; asm volatile("" : "+v"(qp2));   const u32x2 q0 = *(const LAS u32x2*)qp, q1 = *(const LAS u32x2*)qp2; qf[buf][lt2] = as_bf16x8((u32x4){q0.x, q0.y, q1.x, q1.y}); } } while (0)
            QC_LOAD(0, 0);
#pragma unroll
            for (int kk = 0; kk < 8; ++kk) {
                if (kk + 1 < 8) QC_LOAD((kk + 1) & 1, kk + 1);
                u32x4 cw; cw.x = cvt_pk_bf16(Cacc[2 * kk][0], Cacc[2 * kk][1]); cw.y = cvt_pk_bf16(Cacc[2 * kk][2], Cacc[2 * kk][3]);
                cw.z = cvt_pk_bf16(Cacc[2 * kk + 1][0], Cacc[2 * kk + 1][1]); cw.w = cvt_pk_bf16(Cacc[2 * kk + 1][2], Cacc[2 * kk + 1][3]);
                const bf16x8 cf = as_bf16x8(cw);
                __builtin_amdgcn_sched_barrier(0);
#pragma unroll
                for (int lt2 = 0; lt2 < 4; ++lt2) oacc[lt2] = mfma16(cf, qf[kk & 1][lt2], oacc[lt2]);
                __builtin_amdgcn_sched_barrier(0);
            }
#undef QC_LOAD
        }
        __builtin_amdgcn_sched_barrier(0);
        if (REPEAT_PHASE == 63) { __syncthreads(); __syncthreads(); __syncthreads(); }
        if (st + 1 < nsteps) MLSTM_LOAD(st + 1);
        __syncthreads();
        bf16x8 vfr[2];
#pragma unroll
        for (int ks = 0; ks < 2; ++ks) vfr[ks] = *(const LAS bf16x8*)(Vt + (16 * wid + fr) * TP + 32 * ks + 8 * fq);
        bf16x8 sfr[4][2];
#pragma unroll
        for (int lt2 = 0; lt2 < 4; ++lt2)
#pragma unroll
            for (int ks = 0; ks < 2; ++ks) sfr[lt2][ks] = *(const LAS bf16x8*)(Ss + (16 * lt2 + fr) * TP + 32 * ks + 8 * fq);
#pragma unroll
        for (int lt2 = 0; lt2 < 4; ++lt2) { const int l = 16 * lt2 + fr; const float wl = __shfl(winter, l), en = __shfl(eneg, l);
            oacc[lt2] = oacc[lt2] * wl;
#pragma unroll
            for (int ks = 0; ks < 2; ++ks) oacc[lt2] = mfma16(vfr[ks], sfr[lt2][ks], oacc[lt2]);
            const float den = wl * qnS[l] + rsS[l] + rsS[64 + l]; const float inv = 1.0f / fmaxf(fabsf(den), en);
            if (l < L) { u32x2 w; w.x = cvt_pk_bf16(oacc[lt2][0] * inv, oacc[lt2][1] * inv); w.y = cvt_pk_bf16(oacc[lt2][2] * inv, oacc[lt2][3] * inv);
                *(u32x2*)(Hb + (size_t)(rbase + l) * D + h * HD + eh * 128 + 16 * wid + 4 * fq) = w; } }
        __builtin_amdgcn_sched_barrier(0);
        {
            bf16x8 kf[2][2][2];
#define CU_LOAD(buf, g_) do { _Pragma("unroll") for (int t4 = 0; t4 < 2; ++t4) _Pragma("unroll") for (int ks = 0; ks < 2; ++ks) \
                kf[buf][t4][ks] = *(const LAS bf16x8*)(Kt + (16 * (2 * (g_) + t4) + fr) * TP + 32 * ks + 8 * fq); } while (0)
            CU_LOAD(0, 0);
#pragma unroll
            for (int g = 0; g < 8; ++g) {
                if (g + 1 < 8) CU_LOAD((g + 1) & 1, g + 1);
#pragma unroll
                for (int t4 = 0; t4 < 2; ++t4) Cacc[2 * g + t4] = Cacc[2 * g + t4] * decay;
                __builtin_amdgcn_sched_barrier(0);
#pragma unroll
                for (int t4 = 0; t4 < 2; ++t4)
#pragma unroll
                    for (int ks = 0; ks < 2; ++ks) Cacc[2 * g + t4] = mfma16(kf[g & 1][t4][ks], vfr[ks], Cacc[2 * g + t4]);
                __builtin_amdgcn_sched_barrier(0);
            }
#undef CU_LOAD
        }
        __builtin_amdgcn_sched_barrier(0);
        {
            const int d = tid >> 1, half = tid & 1; float a = 0.f;
#pragma unroll
            for (int j = 0; j < 4; ++j) { const u32x4 kv = *(const LAS u32x4*)(Kt + d * TP + 32 * half + 8 * j);
                a += (bf_lo(kv.x) + bf_hi(kv.x)) + (bf_lo(kv.y) + bf_hi(kv.y)) + (bf_lo(kv.z) + bf_hi(kv.z)) + (bf_lo(kv.w) + bf_hi(kv.w)); }
            a += dpp_f<0xB1, 0xF>(a, a);
            if (half == 0) nS[(p ^ 1) * 256 + d] = decay * nS[p * 256 + d] + a;
        }
        m_prev = m_new; p ^= 1;
        __syncthreads();
    }
    { float* cp = C_out + (size_t)(4 * fq) * HD + eh * 128 + 16 * wid + fr;
#pragma unroll
      for (int t = 0; t < 16; ++t) {
#pragma unroll
        for (int i = 0; i < 4; ++i) cp[i * HD] = Cacc[t][i];
        cp += 16 * HD; asm volatile("" : "+v"(cp)); } }
    if (eh == 0) { if (tid < 256) n_out[tid] = nS[p * 256 + tid]; if (tid == 0) *m_out = m_prev; }
    __syncthreads();
}

__device__ __forceinline__ void phase_mlstm(const Frame& F) {
    const bf16_t* Qb = (const bf16_t*)(F.ws + WS_Q); const bf16_t* Kb = (const bf16_t*)(F.ws + WS_K); const bf16_t* Vb = (const bf16_t*)F.out;
    bf16_t* Hb = (bf16_t*)(F.ws + WS_U); const float* GATES = (const float*)(F.ws + WS_GATES);
    for (int it0 = F.bid; it0 < 768; it0 += F.G) {
        const bool prm = it0 < 256; const int it = prm ? it0 : it0 - 256;
        const int b = it >> 4, h = (it >> 1) & 7, eh = it & 1; const size_t bh = (size_t)b * 8 + h;
        mlstm_item(F.lds, Qb, Kb, Vb, Hb, GATES, prm ? b * SEQ : MP + b * DSEQ, prm ? SEQ / 64 : 1, prm ? 64 : DSEQ, h, eh,
                   prm ? nullptr : F.in[5] + bh * 65536, prm ? nullptr : F.in[6] + bh * 256, prm ? 0.f : F.in[7][bh],
                   F.out + (prm ? OUT_CP : OUT_CS) + bh * 65536, F.out + (prm ? OUT_NP : OUT_NS) + bh * 256, F.out + (prm ? OUT_MP : OUT_MS) + bh); }
}

__device__ __forceinline__ void phase_gn(const Frame& F) {
    bf16_t* Hb = (bf16_t*)(F.ws + WS_U); const bf16_t* Ob = (const bf16_t*)(F.ws + WS_O); const float* gnw = F.in[15]; const int lane = __lane_id();
    const int nw = F.G * 8;
    for (int rb = F.bid * 8 + F.wid; rb < M; rb += 2 * nw) {
        u32x4 hv[2][4], ov[2][4]; int rr[2]; bool ok[2];
#pragma unroll
        for (int q = 0; q < 2; ++q) { rr[q] = rb + q * nw; ok[q] = rr[q] < M; if (!ok[q]) rr[q] = rb;
#pragma unroll
            for (int j = 0; j < 4; ++j) { const size_t off = (size_t)rr[q] * D + j * 512 + lane * 8; hv[q][j] = *(const u32x4*)(Hb + off); ov[q][j] = *(const u32x4*)(Ob + off); } }
#pragma unroll
        for (int q = 0; q < 2; ++q)
#pragma unroll
        for (int j = 0; j < 4; ++j) { const int e = j * 512 + lane * 8; const size_t off = (size_t)rr[q] * D + e;
            const u32x4 h4 = hv[q][j], o4 = ov[q][j];
            float v[8];
            v[0] = bf_lo(h4.x) * sigmoidf_(bf_lo(o4.x)); v[1] = bf_hi(h4.x) * sigmoidf_(bf_hi(o4.x)); v[2] = bf_lo(h4.y) * sigmoidf_(bf_lo(o4.y)); v[3] = bf_hi(h4.y) * sigmoidf_(bf_hi(o4.y));
            v[4] = bf_lo(h4.z) * sigmoidf_(bf_lo(o4.z)); v[5] = bf_hi(h4.z) * sigmoidf_(bf_hi(o4.z)); v[6] = bf_lo(h4.w) * sigmoidf_(bf_lo(o4.w)); v[7] = bf_hi(h4.w) * sigmoidf_(bf_hi(o4.w));
            float s = ((v[0] + v[1]) + (v[2] + v[3])) + ((v[4] + v[5]) + (v[6] + v[7]));
#pragma unroll
            for (int o = 16; o >= 1; o >>= 1) s += __shfl_xor(s, o);
            const float mu = s * (1.0f / 256.0f); float qq = 0.f;
#pragma unroll
            for (int k = 0; k < 8; ++k) { v[k] -= mu; qq += v[k] * v[k]; }
#pragma unroll
            for (int o = 16; o >= 1; o >>= 1) qq += __shfl_xor(qq, o);
            const float rstd = rsqrtf(qq * (1.0f / 256.0f) + LN_EPS);
            const f32x4 g0 = *(const f32x4*)(gnw + e), g1 = *(const f32x4*)(gnw + e + 4);
            u32x4 w; w.x = cvt_pk_bf16(v[0] * rstd * g0[0], v[1] * rstd * g0[1]); w.y = cvt_pk_bf16(v[2] * rstd * g0[2], v[3] * rstd * g0[3]);
            w.z = cvt_pk_bf16(v[4] * rstd * g1[0], v[5] * rstd * g1[1]); w.w = cvt_pk_bf16(v[6] * rstd * g1[2], v[7] * rstd * g1[3]);
            if (ok[q]) *(u32x4*)(Hb + off) = w; }
    }
}

template <int MODE, int NSPLIT> __device__ __forceinline__ void phase_ln_rows(const Frame& F, const bf16_t* Xin, bf16_t* X1, const float* gam, const float* bet, const float* part, const float* gate, const bf16_t* x1b) {
    const float* MOD = (const float*)(F.ws + WS_MOD); bf16_t* U = (bf16_t*)(F.ws + WS_U); const int lane = __lane_id();
    const int nw = F.G * 8;
    for (int rb = F.bid * 8 + F.wid; rb < M; rb += 2 * nw) {
        float v[2][32]; int rr[2]; bool ok[2];
#pragma unroll
        for (int q = 0; q < 2; ++q) { rr[q] = rb + q * nw; ok[q] = rr[q] < M; if (!ok[q]) rr[q] = rb;
            if (rr[q] >= MP) {
                const int rs = rr[q] - MP; const float* gp = gate + (size_t)cond_of_row(rr[q]) * MODW;
#pragma unroll
                for (int j = 0; j < 4; ++j) { const int e = j * 512 + lane * 8; f32x4 t0 = (f32x4){0.f, 0.f, 0.f, 0.f}, t1 = t0;
#pragma unroll
                    for (int kb = 0; kb < NSPLIT; ++kb) { const float* pp = part + ((size_t)kb * MS + rs) * D + e; t0 += *(const f32x4*)pp; t1 += *(const f32x4*)(pp + 4); }
                    f32x4 s0, s1;
                    if (MODE == 0) { const float* sp = F.in[1] + (size_t)rs * D + e; s0 = *(const f32x4*)sp; s1 = *(const f32x4*)(sp + 4); }
                    else { const u32x4 w = *(const u32x4*)(x1b + (size_t)rr[q] * D + e); s0 = (f32x4){bf_lo(w.x), bf_hi(w.x), bf_lo(w.y), bf_hi(w.y)}; s1 = (f32x4){bf_lo(w.z), bf_hi(w.z), bf_lo(w.w), bf_hi(w.w)}; }
                    const f32x4 g0 = *(const f32x4*)(gp + e), g1 = *(const f32x4*)(gp + e + 4);
                    s0 = s0 * ALPHA + g0 * t0; s1 = s1 * ALPHA + g1 * t1;
#pragma unroll
                    for (int k = 0; k < 4; ++k) { v[q][8 * j + k] = s0[k]; v[q][8 * j + 4 + k] = s1[k]; } }
            } else
#pragma unroll
            for (int j = 0; j < 4; ++j) { const u32x4 w = *(const u32x4*)(Xin + (size_t)rr[q] * D + j * 512 + lane * 8);
                v[q][8 * j + 0] = bf_lo(w.x); v[q][8 * j + 1] = bf_hi(w.x); v[q][8 * j + 2] = bf_lo(w.y); v[q][8 * j + 3] = bf_hi(w.y);
                v[q][8 * j + 4] = bf_lo(w.z); v[q][8 * j + 5] = bf_hi(w.z); v[q][8 * j + 6] = bf_lo(w.w); v[q][8 * j + 7] = bf_hi(w.w); } }
#pragma unroll
        for (int q = 0; q < 2; ++q) {
            float s = 0.f;
#pragma unroll
            for (int k = 0; k < 32; ++k) s += v[q][k];
            const float mu = wave_sum(s) * (1.0f / D); float qq = 0.f;
#pragma unroll
            for (int k = 0; k < 32; ++k) { v[q][k] -= mu; qq += v[q][k] * v[q][k]; }
            const float rstd = rsqrtf(wave_sum(qq) * (1.0f / D) + LN_EPS); float s2 = 0.f;
#pragma unroll
            for (int j = 0; j < 4; ++j) { const int e = j * 512 + lane * 8;
                const f32x4 g0 = *(const f32x4*)(gam + e), g1 = *(const f32x4*)(gam + e + 4), b0 = *(const f32x4*)(bet + e), b1 = *(const f32x4*)(bet + e + 4);
#pragma unroll
                for (int k = 0; k < 4; ++k) { v[q][8 * j + k] = v[q][8 * j + k] * rstd * g0[k] + b0[k]; v[q][8 * j + 4 + k] = v[q][8 * j + 4 + k] * rstd * g1[k] + b1[k]; }
#pragma unroll
                for (int k = 0; k < 8; ++k) s2 += v[q][8 * j + k];
                if (ok[q]) {
                    if (MODE == 0) { u32x4 w; w.x = cvt_pk_bf16(v[q][8 * j], v[q][8 * j + 1]); w.y = cvt_pk_bf16(v[q][8 * j + 2], v[q][8 * j + 3]); w.z = cvt_pk_bf16(v[q][8 * j + 4], v[q][8 * j + 5]); w.w = cvt_pk_bf16(v[q][8 * j + 6], v[q][8 * j + 7]);
                        *(u32x4*)(X1 + (size_t)rr[q] * D + e) = w; }
                    else { float* op = F.out + (size_t)rr[q] * D + e; *(f32x4*)op = (f32x4){v[q][8 * j], v[q][8 * j + 1], v[q][8 * j + 2], v[q][8 * j + 3]}; *(f32x4*)(op + 4) = (f32x4){v[q][8 * j + 4], v[q][8 * j + 5], v[q][8 * j + 6], v[q][8 * j + 7]}; } } }
            if (MODE == 0) {
                const float mu2 = wave_sum(s2) * (1.0f / D); float q2 = 0.f;
#pragma unroll
                for (int k = 0; k < 32; ++k) { v[q][k] -= mu2; q2 += v[q][k] * v[q][k]; }
                const float rstd2 = rsqrtf(wave_sum(q2) * (1.0f / D) + LN_EPS);
                const float* sh = MOD + (size_t)cond_of_row(rr[q]) * MODW + 3 * D; const float* sc = sh + D;
#pragma unroll
                for (int j = 0; j < 4; ++j) { const int e = j * 512 + lane * 8;
                    const f32x4 c0 = *(const f32x4*)(sc + e), c1 = *(const f32x4*)(sc + e + 4), h0 = *(const f32x4*)(sh + e), h1 = *(const f32x4*)(sh + e + 4);
                    float o[8];
#pragma unroll
                    for (int k = 0; k < 4; ++k) { o[k] = v[q][8 * j + k] * rstd2 * (c0[k] + 1.0f) + h0[k]; o[4 + k] = v[q][8 * j + 4 + k] * rstd2 * (c1[k] + 1.0f) + h1[k]; }
                    u32x4 w; w.x = cvt_pk_bf16(o[0], o[1]); w.y = cvt_pk_bf16(o[2], o[3]); w.z = cvt_pk_bf16(o[4], o[5]); w.w = cvt_pk_bf16(o[6], o[7]);
                    if (ok[q]) *(u32x4*)(U + (size_t)rr[q] * D + e) = w; }
            }
        }
    }
}

__global__ void __launch_bounds__(NTHREADS, 2) fwd_kernel(KArgs a) {
    extern __shared__ __attribute__((aligned(16))) unsigned char lds_raw[];
    Frame F;
    F.lds = (LAS unsigned char*)lds_raw;
    F.in = a.in;
    F.out = a.out; F.ws = a.ws;
    F.tid = threadIdx.x; F.lane = F.tid & 63; F.wid = __builtin_amdgcn_readfirstlane(F.tid >> 6); F.G = gridDim.x; F.bid = blockIdx.x;
    const int lo = a.ph_lo, hi = a.ph_hi;
    unsigned char* ws = a.ws; unsigned char* ob = (unsigned char*)a.out;
    bf16_t* U = (bf16_t*)(ws + WS_U); bf16_t* Qb = (bf16_t*)(ws + WS_Q); bf16_t* Kb = (bf16_t*)(ws + WS_K); bf16_t* Ob = (bf16_t*)(ws + WS_O);
    bf16_t* GA = (bf16_t*)(ws + WS_GA); bf16_t* GB = (bf16_t*)(ws + WS_GB);
    bf16_t* Vb = (bf16_t*)ob; bf16_t* Pb = (bf16_t*)(ob + SZ_TOK); bf16_t* Yb = (bf16_t*)(ob + SZ_TOK + (size_t)M * PW * 2);
    bf16_t* TMP = Qb; bf16_t* MRG = Kb; bf16_t* HM = Qb; bf16_t* AOUT = Pb;
    float* PART = (float*)(ws + WS_PART);
    bf16_t* XA = GA; bf16_t* XB = GB;
    const float* MOD = (const float*)(ws + WS_MOD);
#ifndef ONLY_PHASE
#define ONLY_PHASE -1
#endif
#define IN(k) ((ONLY_PHASE < 0 || ONLY_PHASE == (k)) && lo <= (k) && (k) < hi)
#define SEAM(k) do { if (IN(k) && IN((k) + 1)) { if ((k) == 0) cg::this_grid().sync(); else xcd_barrier(xbar); } } while (0)
    volatile LAS unsigned* xst = (volatile LAS unsigned*)(F.lds + LDS_BYTES - 16);
    if (F.tid < 4) xst[F.tid] = 0u;
    __syncthreads();
    XcdBarrier xbar; xbar.bar = (unsigned*)ws; xbar.x = 0; xbar.st = xst;
    if (hi - lo > 1) xbar = xcd_barrier_post((unsigned*)ws, xst);

    if (IN(0)) REP(0) phase_prologue(F);
    SEAM(0);
    if (IN(1)) REP(1) phase_ln_in(F);
    SEAM(1);
    if (IN(2)) REP(2) { pg8::Gemm g{U, (const bf16_t*)(ws + WS_WIN), D, D, D, 0, D}; pg8::StaticOrder S; S.init(M / 256, NMAIN / 256, F.G, F.bid);
        EpiProj E{Pb, Qb, Kb, Vb, Ob, GA, GB}; pg8::gemm_phase<EpiProj, pg8::StaticOrder, pg8::NoSub, true>(F.lds, g, S, E); }
    SEAM(2);
    if (IN(3)) REP(3) { REP(30) phase_pool(F); REP(31) phase_mlstm(F); }
    SEAM(3);
    if (IN(4)) { pg8::Gemm g{Yb, (const bf16_t*)(ws + WS_WPOOL), PW, 256, 256, 512, 256}; pg8::StaticOrder S; S.init(M / 256, 4, F.G, F.bid);
        EpiPool E{AOUT, F.in[14]}; pg8::gemm_phase<EpiPool>(F.lds, g, S, E);
        phase_gn(F); }
    SEAM(4);
    if (IN(5)) REP(5) { pg8::Gemm g{AOUT, (const bf16_t*)(ws + WS_WPA), PW, PW, PW, 0, PW / 4}; pg8::SplitOrder S; S.init(MP / 256, D / 256, MS / 256, 4, F.G, F.bid);
        EpiMerge<0> E{GA, nullptr, TMP}; EpiPartial EP{PART}; pg8::gemm_phase<EpiMerge<0>, pg8::SplitOrder, EpiPartial, true>(F.lds, g, S, E, EP); }
    if (IN(6)) REP(6) { pg8::Gemm g{U, (const bf16_t*)(ws + WS_WPB), D, D, D, 0, D / 4}; pg8::SplitOrder S; S.init(MP / 256, D / 256, MS / 256, 4, F.G, F.bid);
        EpiMerge<1> E{GB, TMP, MRG}; EpiPartial EP{PART + (size_t)4 * MS * D}; pg8::gemm_phase<EpiMerge<1>, pg8::SplitOrder, EpiPartial, true>(F.lds, g, S, E, EP); }
    SEAM(6);
    if (IN(7)) {
        for (int idx = F.bid * NTHREADS + F.tid; idx < MS * (D / 8); idx += F.G * NTHREADS) { const int rs = idx >> 8, c = (idx & 255) * 8; const size_t off = (size_t)(MP + rs) * D + c;
            const u32x4 ga4 = *(const u32x4*)(GA + off), gb4 = *(const u32x4*)(GB + off);
            f32x4 a0 = (f32x4){0.f, 0.f, 0.f, 0.f}, a1 = a0, b0 = a0, b1 = a0;
#pragma unroll
            for (int kb = 0; kb < 4; ++kb) { const float* pa = PART + ((size_t)kb * MS + rs) * D + c; const float* pb = pa + (size_t)4 * MS * D;
                a0 += *(const f32x4*)pa; a1 += *(const f32x4*)(pa + 4); b0 += *(const f32x4*)pb; b1 += *(const f32x4*)(pb + 4); }
            float o[8];
            o[0] = sigmoidf_(bf_lo(ga4.x)) * a0[0] + sigmoidf_(bf_lo(gb4.x)) * b0[0]; o[1] = sigmoidf_(bf_hi(ga4.x)) * a0[1] + sigmoidf_(bf_hi(gb4.x)) * b0[1];
            o[2] = sigmoidf_(bf_lo(ga4.y)) * a0[2] + sigmoidf_(bf_lo(gb4.y)) * b0[2]; o[3] = sigmoidf_(bf_hi(ga4.y)) * a0[3] + sigmoidf_(bf_hi(gb4.y)) * b0[3];
            o[4] = sigmoidf_(bf_lo(ga4.z)) * a1[0] + sigmoidf_(bf_lo(gb4.z)) * b1[0]; o[5] = sigmoidf_(bf_hi(ga4.z)) * a1[1] + sigmoidf_(bf_hi(gb4.z)) * b1[1];
            o[6] = sigmoidf_(bf_lo(ga4.w)) * a1[2] + sigmoidf_(bf_lo(gb4.w)) * b1[2]; o[7] = sigmoidf_(bf_hi(ga4.w)) * a1[3] + sigmoidf_(bf_hi(gb4.w)) * b1[3];
            u32x4 w; w.x = cvt_pk_bf16(o[0], o[1]); w.y = cvt_pk_bf16(o[2], o[3]); w.z = cvt_pk_bf16(o[4], o[5]); w.w = cvt_pk_bf16(o[6], o[7]);
            *(u32x4*)(MRG + off) = w; }
        if (hi - lo > 1) xcd_barrier(xbar);
    }
    if (IN(7)) REP(7) { pg8::Gemm g{MRG, (const bf16_t*)(ws + WS_WOUT), D, D, D, 0, D / 8}; pg8::SplitOrder S; S.init(MP / 256, D / 256, MS / 256, 8, F.G, F.bid);
        EpiRes<0> E{F.in[0], F.in[1], nullptr, MOD + 2 * D, XA}; EpiPartial EP{PART}; pg8::gemm_phase<EpiRes<0>, pg8::SplitOrder, EpiPartial, true>(F.lds, g, S, E, EP); }
    SEAM(7);
    if (IN(8)) phase_ln_rows<0, 8>(F, XA, XB, F.in[19], F.in[20], PART, MOD + 2 * D, nullptr);
    SEAM(8);
    if (IN(9)) REP(9) { pg8::Gemm g{U, (const bf16_t*)(ws + WS_WGU), D, D, D, 0, D}; pg8::StaticOrder S; S.init(M / 256, 2 * DFF / 256, F.G, F.bid);
        EpiSwiglu E{HM}; pg8::gemm_phase<EpiSwiglu, pg8::StaticOrder, pg8::NoSub, true>(F.lds, g, S, E); }
    SEAM(9);
    if (IN(10)) { pg8::Gemm g{HM, (const bf16_t*)(ws + WS_WDOWN), DFF, DFF, DFF, 0, DFF / 4}; pg8::SplitOrder S; S.init(MP / 256, D / 256, MS / 256, 4, F.G, F.bid);
        EpiRes<1> E{nullptr, nullptr, XB, MOD + 5 * D, XA}; EpiPartial EP{PART}; pg8::gemm_phase<EpiRes<1>, pg8::SplitOrder, EpiPartial, true>(F.lds, g, S, E, EP); }
    SEAM(10);
    if (IN(11)) phase_ln_rows<1, 4>(F, XA, nullptr, F.in[24], F.in[25], PART, MOD + 5 * D, XB);
#undef IN
#undef SEAM
}

extern "C" void kernel_launch(void* const* d_in, const int* in_sizes, int n_in, void* d_out, int out_size, void* d_ws, size_t ws_size, hipStream_t stream) {
    static int grid = 0;
    if (grid == 0) {
        if (n_in != 26 || in_sizes[0] != MP * D || (size_t)out_size != OUT_END || ws_size < WS_END) {
            fprintf(stderr, "kernel_launch: unexpected shapes (n_in %d, in0 %d, out %d, ws %zu; need ws >= %zu)\n", n_in, n_in > 0 ? in_sizes[0] : -1, out_size, ws_size, (size_t)WS_END); grid = -1; return; }
        int dev = 0, cus = 0, per_cu = 0;
        if (hipGetDevice(&dev) != hipSuccess || hipDeviceGetAttribute(&cus, hipDeviceAttributeMultiprocessorCount, dev) != hipSuccess) { grid = -1; return; }
        if (hipFuncSetAttribute((const void*)fwd_kernel, hipFuncAttributeMaxDynamicSharedMemorySize, LDS_BYTES) != hipSuccess) { fprintf(stderr, "kernel_launch: hipFuncSetAttribute failed\n"); grid = -1; return; }
        if (hipOccupancyMaxActiveBlocksPerMultiprocessor(&per_cu, (const void*)fwd_kernel, NTHREADS, LDS_BYTES) != hipSuccess || per_cu < 1) { fprintf(stderr, "kernel_launch: occupancy query says %d\n", per_cu); per_cu = 1; }
        (void)hipGetLastError();
        grid = cus * 1;
    }
    if (grid < 0) return;
    if (hipMemsetAsync(d_ws, 0, 16384, stream) != hipSuccess) { fprintf(stderr, "kernel_launch: hipMemsetAsync failed\n"); return; }
    KArgs a{};
    for (int i = 0; i < 26; ++i) a.in[i] = (const float*)d_in[i];
    a.out = (float*)d_out; a.ws = (unsigned char*)d_ws;
#if ONE_LAUNCH
    a.ph_lo = 0; a.ph_hi = NPHASES;
    void* args[] = {&a};
    hipError_t e = hipLaunchCooperativeKernel((const void*)fwd_kernel, dim3(grid), dim3(NTHREADS), args, LDS_BYTES, stream);
    if (e != hipSuccess) fprintf(stderr, "kernel_launch: cooperative launch failed: %s (grid %d)\n", hipGetErrorString(e), grid);
#else
    for (int ph = 0; ph < NPHASES; ++ph) { a.ph_lo = ph; a.ph_hi = ph + 1;
        hipLaunchKernelGGL(fwd_kernel, dim3(grid), dim3(NTHREADS), LDS_BYTES, stream, a); }
#endif
}
```
